# Optimizing an MI355X kernel written in HIP

```python
import math
import jax, jax.numpy as jnp
from jax import lax
import numpy as np

D_MODEL = 1024
BATCH = 2
SEQ = 8192
DEPTH = 1

HEAD_DIM = 64
DIL_GROUPS = ((128, 1), (512, 4), (2048, 16))
DIL_HEADS_PER_GROUP = 4
N_DIL_HEADS = DIL_HEADS_PER_GROUP * len(DIL_GROUPS)
N_SB_HEADS = 8
DIL_WIDTH = N_DIL_HEADS * HEAD_DIM
DIL_OUT_WIDTH = DIL_HEADS_PER_GROUP * HEAD_DIM
SB_WIDTH = N_SB_HEADS * HEAD_DIM
D_FF = 4 * D_MODEL
BLOCK = 128
RMS_EPS = 1e-6
NEG_INF = -1e30
IN_COLS = 3 * DIL_WIDTH + 3 * SB_WIDTH + 2 * D_MODEL
SPLITS = (DIL_WIDTH, 2 * DIL_WIDTH, 3 * DIL_WIDTH,
          3 * DIL_WIDTH + SB_WIDTH, 3 * DIL_WIDTH + 2 * SB_WIDTH, 3 * DIL_WIDTH + 3 * SB_WIDTH,
          3 * DIL_WIDTH + 3 * SB_WIDTH + D_MODEL)

kernel_name = "hybrid_dilated_stickbreaking_gated_block"


def rmsnorm(x, g):
    xf = x.astype(jnp.float32)
    y = xf * lax.rsqrt(jnp.mean(xf * xf, axis=-1, keepdims=True) + RMS_EPS)
    return (y * g.astype(jnp.float32)).astype(x.dtype)


def alibi_slopes(n):
    return jnp.exp2(-8.0 * jnp.arange(1, n + 1, dtype=jnp.float32) / n)


def dilated_window_group(q, k, v, slopes, window, dilation):
    b, s, h, dh = q.shape
    n_steps = window // dilation
    nb = -(-s // (dilation * BLOCK))
    sub_len = nb * BLOCK
    s_pad = sub_len * dilation

    def to_blocks(t):
        t = jnp.pad(t, ((0, 0), (0, s_pad - s), (0, 0), (0, 0)))
        t = t.reshape(b, sub_len, dilation, h, dh)
        t = t.transpose(0, 2, 3, 1, 4)
        return t.reshape(b, dilation, h, nb, BLOCK, dh)

    qb, kb, vb = to_blocks(q), to_blocks(k), to_blocks(v)

    def with_prev(t):
        prev = jnp.pad(t[:, :, :, :-1], ((0, 0), (0, 0), (0, 0), (1, 0), (0, 0), (0, 0)))
        return jnp.concatenate([prev, t], axis=4)

    kk, vv = with_prev(kb), with_prev(vb)
    scores = jnp.einsum('brhnqd,brhnkd->brhnqk', qb, kk).astype(jnp.float32) / math.sqrt(dh)
    qi = jnp.arange(BLOCK)[:, None]
    kj = jnp.arange(2 * BLOCK)[None, :]
    steps = qi + BLOCK - kj
    key_sub_idx = jnp.arange(nb)[:, None, None] * BLOCK + kj[None] - BLOCK
    valid = (steps >= 0) & (steps <= n_steps) & (key_sub_idx >= 0)
    bias = -slopes[:, None, None].astype(jnp.float32) * (steps * dilation).astype(jnp.float32)
    logits = scores + bias[None, None, :, None]
    logits = jnp.where(valid[None, None, None], logits, NEG_INF)
    lse = jax.nn.logsumexp(logits, axis=-1)
    p = jnp.exp(logits - lse[..., None])
    o = jnp.einsum('brhnqk,brhnkd->brhnqd', p.astype(v.dtype), vv)

    def from_blocks(t):
        extra = t.shape[5:]
        t = t.reshape((b, dilation, h, sub_len) + extra)
        t = jnp.moveaxis(t, 3, 1)
        t = t.reshape((b, s_pad, h) + extra)
        return t[:, :s]

    return from_blocks(o), from_blocks(lse)


def dilated_attention(q, k, v):
    b, s = q.shape[:2]
    slopes = alibi_slopes(N_DIL_HEADS)
    outs, lses = [], []
    for g, (window, dilation) in enumerate(DIL_GROUPS):
        sl = slice(g * DIL_HEADS_PER_GROUP, (g + 1) * DIL_HEADS_PER_GROUP)
        o, l = dilated_window_group(q[:, :, sl], k[:, :, sl], v[:, :, sl], slopes[sl], window, dilation)
        outs.append(o)
        lses.append(l)
    o_all = jnp.stack(outs, axis=0).astype(jnp.float32)
    w = jax.nn.softmax(jnp.stack(lses, axis=0), axis=0)
    out = jnp.sum(w[..., None] * o_all, axis=0).astype(q.dtype)
    return out.reshape(b, s, DIL_OUT_WIDTH)


def stick_breaking_attention(q, k, v):
    b, s, h, dh = q.shape
    nb = s // BLOCK
    scale = 1.0 / math.sqrt(dh)
    kt = k.transpose(0, 2, 1, 3)
    vt = v.transpose(0, 2, 1, 3)
    q_blocks = q.transpose(0, 2, 1, 3).reshape(b, h, nb, BLOCK, dh).transpose(2, 0, 1, 3, 4)
    key_pos = jnp.arange(s)

    def one_block(args):
        i, q_blk = args
        z = jnp.einsum('bhqd,bhkd->bhqk', q_blk, kt).astype(jnp.float32) * scale
        q_pos = i * BLOCK + jnp.arange(BLOCK)
        causal = key_pos[None, :] < q_pos[:, None]
        log_one_minus = jnp.where(causal, jax.nn.log_sigmoid(-z), 0.0)
        suffix = lax.cumsum(log_one_minus, axis=3, reverse=True) - log_one_minus
        log_a = jax.nn.log_sigmoid(z) + suffix
        a = jnp.where(causal, jnp.exp(log_a), 0.0)
        return jnp.einsum('bhqk,bhkd->bhqd', a.astype(vt.dtype), vt)

    o_blocks = lax.map(one_block, (jnp.arange(nb), q_blocks))
    return o_blocks.transpose(1, 0, 3, 2, 4).reshape(b, s, h * dh)


def setup_inputs(seed: int = 0) -> dict:
    key = jax.random.key(seed)
    ks = jax.random.split(key, 12)
    f32 = jnp.float32
    x = jax.random.normal(ks[0], (BATCH, SEQ, D_MODEL), f32)
    norm_mix_g = 1.0 + 0.02 * jax.random.normal(ks[1], (DEPTH, D_MODEL), f32)
    w_in = jax.random.normal(ks[2], (DEPTH, D_MODEL, IN_COLS), f32) * D_MODEL ** -0.5
    b_gate = 0.02 * jax.random.normal(ks[3], (DEPTH, 2 * D_MODEL), f32)
    w_up_dil = jax.random.normal(ks[4], (DEPTH, DIL_OUT_WIDTH, D_MODEL), f32) * DIL_OUT_WIDTH ** -0.5
    w_up_sb = jax.random.normal(ks[5], (DEPTH, SB_WIDTH, D_MODEL), f32) * SB_WIDTH ** -0.5
    w_out = jax.random.normal(ks[6], (DEPTH, D_MODEL, D_MODEL), f32) * D_MODEL ** -0.5
    norm_mlp_g = 1.0 + 0.02 * jax.random.normal(ks[7], (DEPTH, D_MODEL), f32)
    w_mlp_in = jax.random.normal(ks[8], (DEPTH, D_MODEL, D_FF), f32) * D_MODEL ** -0.5
    w_mlp_out = jax.random.normal(ks[9], (DEPTH, D_FF, D_MODEL), f32) * D_FF ** -0.5
    norm_final_g = 1.0 + 0.02 * jax.random.normal(ks[10], (D_MODEL,), f32)
    return {"x": x, "norm_mix_g": norm_mix_g, "w_in": w_in, "b_gate": b_gate,
            "w_up_dil": w_up_dil, "w_up_sb": w_up_sb, "w_out": w_out,
            "norm_mlp_g": norm_mlp_g, "w_mlp_in": w_mlp_in, "w_mlp_out": w_mlp_out,
            "norm_final_g": norm_final_g}


def reference(x, norm_mix_g, w_in, b_gate, w_up_dil, w_up_sb, w_out,
              norm_mlp_g, w_mlp_in, w_mlp_out, norm_final_g):
    b, s, _ = x.shape
    for layer in range(DEPTH):
        h = rmsnorm(x, norm_mix_g[layer])
        proj = h @ w_in[layer]
        q_a, k_a, v_a, q_b, k_b, v_b, gl_a, gl_b = jnp.split(proj, SPLITS, axis=-1)
        heads_a = lambda t: t.reshape(b, s, N_DIL_HEADS, HEAD_DIM)
        heads_b = lambda t: t.reshape(b, s, N_SB_HEADS, HEAD_DIM)
        o_a = dilated_attention(heads_a(q_a), heads_a(k_a), heads_a(v_a))
        o_b = stick_breaking_attention(heads_b(q_b), heads_b(k_b), heads_b(v_b))
        bg_a, bg_b = jnp.split(b_gate[layer], 2)
        g_a = jax.nn.sigmoid(gl_a + bg_a)
        g_b = jax.nn.sigmoid(gl_b + bg_b)
        merged = g_a * (o_a @ w_up_dil[layer]) + g_b * (o_b @ w_up_sb[layer])
        x = x + merged @ w_out[layer]
        h2 = rmsnorm(x, norm_mlp_g[layer])
        x = x + jnp.square(jax.nn.relu(h2 @ w_mlp_in[layer])) @ w_mlp_out[layer]
    return rmsnorm(x, norm_final_g)
```

```cpp
#include <hip/hip_cooperative_groups.h>
#include <hip/hip_runtime.h>
#include <cstdio>
#include <cstdint>
namespace pg8 {
#define PG8_LAS __attribute__((address_space(3)))
typedef unsigned short bf16_t;
typedef short bf16x8 __attribute__((ext_vector_type(8)));
typedef float f32x4 __attribute__((ext_vector_type(4)));
typedef unsigned u32x4 __attribute__((ext_vector_type(4)));
constexpr int BM = 256, BK = 64, HALF = 128, HTB = HALF * BK * 2  , STAGE_BYTES = 8 * HTB, NXCD = 8, WGM = 8;

__host__ __device__ __forceinline__ int lds_byte(int r, int c) { const int st = (r >> 4) * 2 + (c >> 5), rr = r & 15, cc = c & 31, ob = rr * 64 + cc * 2; return st * 1024 + (ob ^ (((ob >> 9) & 1) << 5)); }
__host__ __device__ __forceinline__ void stage_rc(int b, int& R, int& C) { const int st = b / 1024, sb = b % 1024, swz = sb ^ (((sb >> 9) & 1) << 5); R = (st >> 1) * 16 + swz / 64; C = (st & 1) * 32 + (swz % 64) / 2; }
__host__ __device__ __forceinline__ int perm32(int rho) { const int n = rho >> 4, i = rho & 15; return 8 * (i >> 2) + 4 * n + (i & 3); }

struct Unit { int pm, pn; };
struct Gemm { const bf16_t* A; const bf16_t* Bt; int M, N, K; };

struct StaticOrder {
    int nM, nN, nwg, G, c;
    __host__ __device__ void init(int M, int N, int G_, int c_) { nM = M / BM; nN = N / BM; nwg = nM * nN; G = G_; c = c_; }
    __host__ __device__ bool next(int i, Unit& u) const {
        const long L = (long)i * G + c; if (L >= nwg) return false;
        int wgid = (int)L; { const int q = nwg / NXCD, r = nwg % NXCD, xcd = wgid % NXCD, off = wgid / NXCD; wgid = (xcd < r ? xcd * (q + 1) : r * (q + 1) + (xcd - r) * q) + off; }
        const int nig = WGM * nN, gid = wgid / nig, fm = gid * WGM, gsz = (nM - fm) < WGM ? (nM - fm) : WGM;
        u.pm = fm + ((wgid % nig) % gsz); u.pn = (wgid % nig) / gsz; return true;
    }
    __device__ __forceinline__ void a_ready(const Unit&) const {}
    __device__ __forceinline__ void done(const Unit&) const {}
};


__device__ __forceinline__ unsigned cvt_pk_bf16(float lo, float hi) { typedef float f2_t __attribute__((ext_vector_type(2))); typedef __bf16 b2_t __attribute__((ext_vector_type(2))); f2_t v = {lo, hi}; b2_t b = __builtin_convertvector(v, b2_t); return __builtin_bit_cast(unsigned, b); }
__device__ __forceinline__ float bf_lo(unsigned w) { return __builtin_bit_cast(float, w << 16); }
__device__ __forceinline__ float bf_hi(unsigned w) { return __builtin_bit_cast(float, w & 0xffff0000u); }
__device__ __forceinline__ u32x4 pack8(f32x4 v0, f32x4 v1) { u32x4 w; w.x = cvt_pk_bf16(v0[0], v0[1]); w.y = cvt_pk_bf16(v0[2], v0[3]); w.z = cvt_pk_bf16(v1[0], v1[1]); w.w = cvt_pk_bf16(v1[2], v1[3]); return w; }
constexpr float QSCALE = 0.125f * 1.4426950408889634f;
constexpr int LD_QKV = 3840, LD_G = 2048;

struct EpiProj {
    static constexpr bool PERM = true, AFTER_DRAIN = false;
    bf16_t* qkv; bf16_t* gates; const float* bgate;
    __device__ __forceinline__ void operator()(const f32x4 (&acc)[2][2][4][2], const Unit& u, int wr, int wc, int fr, int fq) const {
        const int row0 = u.pm * BM + wr * 64 + fr, cw = wc * 32 + 8 * fq;
        if (u.pn < 15) {
            const float sc = (u.pn < 3 || u.pn == 9 || u.pn == 10) ? QSCALE : 1.f;
            bf16_t* base = qkv + u.pn * BM + cw;
#pragma unroll
            for (int ai = 0; ai < 2; ++ai)
#pragma unroll
                for (int m = 0; m < 4; ++m) { bf16_t* rowp = base + (size_t)(row0 + ai * HALF + m * 16) * LD_QKV;
#pragma unroll
                    for (int bj = 0; bj < 2; ++bj) *(u32x4*)(rowp + bj * HALF) = pack8(acc[ai][bj][m][0] * sc, acc[ai][bj][m][1] * sc); }
        } else {
            const int gc = (u.pn - 15) * BM + cw;
            f32x4 bv[2][2];
#pragma unroll
            for (int bj = 0; bj < 2; ++bj)
#pragma unroll
                for (int n = 0; n < 2; ++n) bv[bj][n] = *(const f32x4*)(bgate + gc + bj * HALF + 4 * n);
            bf16_t* base = gates + gc;
#pragma unroll
            for (int ai = 0; ai < 2; ++ai)
#pragma unroll
                for (int m = 0; m < 4; ++m) { bf16_t* rowp = base + (size_t)(row0 + ai * HALF + m * 16) * LD_G;
#pragma unroll
                    for (int bj = 0; bj < 2; ++bj) { f32x4 v[2];
#pragma unroll
                        for (int n = 0; n < 2; ++n) { const f32x4 z = acc[ai][bj][m][n] + bv[bj][n];
#pragma unroll
                            for (int e = 0; e < 4; ++e) v[n][e] = __builtin_amdgcn_rcpf(1.f + __builtin_amdgcn_exp2f(-1.4426950408889634f * z[e])); }
                        *(u32x4*)(rowp + bj * HALF) = pack8(v[0], v[1]); } }
        }
    }
};
template <bool FIRST> struct EpiUp {
    static constexpr bool PERM = true, AFTER_DRAIN = false;
    bf16_t* merged; const bf16_t* gates; int gofs;
    __device__ __forceinline__ void operator()(const f32x4 (&acc)[2][2][4][2], const Unit& u, int wr, int wc, int fr, int fq) const {
        const int row0 = u.pm * BM + wr * 64 + fr, col0 = u.pn * BM + wc * 32 + 8 * fq;
#pragma unroll
        for (int ai = 0; ai < 2; ++ai)
#pragma unroll
            for (int m = 0; m < 4; ++m) { const size_t row = (size_t)(row0 + ai * HALF + m * 16);
#pragma unroll
                for (int bj = 0; bj < 2; ++bj) { const int col = col0 + bj * HALF;
                    const u32x4 gw = *(const u32x4*)(gates + row * LD_G + gofs + col);
                    f32x4 v0 = acc[ai][bj][m][0], v1 = acc[ai][bj][m][1];
                    v0[0] *= bf_lo(gw.x); v0[1] *= bf_hi(gw.x); v0[2] *= bf_lo(gw.y); v0[3] *= bf_hi(gw.y);
                    v1[0] *= bf_lo(gw.z); v1[1] *= bf_hi(gw.z); v1[2] *= bf_lo(gw.w); v1[3] *= bf_hi(gw.w);
                    bf16_t* op = merged + row * 1024 + col;
                    if (!FIRST) { const u32x4 pw = *(const u32x4*)op;
                        v0[0] += bf_lo(pw.x); v0[1] += bf_hi(pw.x); v0[2] += bf_lo(pw.y); v0[3] += bf_hi(pw.y);
                        v1[0] += bf_lo(pw.z); v1[1] += bf_hi(pw.z); v1[2] += bf_lo(pw.w); v1[3] += bf_hi(pw.w); }
                    *(u32x4*)op = pack8(v0, v1); } }
    }
};
struct EpiRes {
    static constexpr bool PERM = true, AFTER_DRAIN = false;
    const float* base; float* out;
    __device__ __forceinline__ void operator()(const f32x4 (&acc)[2][2][4][2], const Unit& u, int wr, int wc, int fr, int fq) const {
        const int row0 = u.pm * BM + wr * 64 + fr, col0 = u.pn * BM + wc * 32 + 8 * fq;
#pragma unroll
        for (int ai = 0; ai < 2; ++ai)
#pragma unroll
            for (int m = 0; m < 4; ++m) { const size_t ro = (size_t)(row0 + ai * HALF + m * 16) * 1024 + col0;
#pragma unroll
                for (int bj = 0; bj < 2; ++bj)
#pragma unroll
                    for (int n = 0; n < 2; ++n) { const size_t off = ro + bj * HALF + 4 * n; *(f32x4*)(out + off) = *(const f32x4*)(base + off) + acc[ai][bj][m][n]; } }
    }
};
struct EpiRelu2 {
    static constexpr bool PERM = true, AFTER_DRAIN = false;
    bf16_t* O;
    __device__ __forceinline__ void operator()(const f32x4 (&acc)[2][2][4][2], const Unit& u, int wr, int wc, int fr, int fq) const {
        const int row0 = u.pm * BM + wr * 64 + fr, col0 = u.pn * BM + wc * 32 + 8 * fq;
#pragma unroll
        for (int ai = 0; ai < 2; ++ai)
#pragma unroll
            for (int m = 0; m < 4; ++m) { bf16_t* rowp = O + (size_t)(row0 + ai * HALF + m * 16) * 4096 + col0;
#pragma unroll
                for (int bj = 0; bj < 2; ++bj) { f32x4 v[2];
#pragma unroll
                    for (int n = 0; n < 2; ++n) { const f32x4 z = acc[ai][bj][m][n];
#pragma unroll
                        for (int e = 0; e < 4; ++e) { const float r = z[e] > 0.f ? z[e] : 0.f; v[n][e] = r * r; } }
                    *(u32x4*)(rowp + bj * HALF) = pack8(v[0], v[1]); } }
    }
};

template <class Epi, class Sched, bool ALIGN_EPI = false, bool SP2 = false>
__device__ __forceinline__ void gemm_phase(PG8_LAS unsigned char* lds, const Gemm g, const Sched& S, const Epi& E) {
    const int tid = threadIdx.x, wid = __builtin_amdgcn_readfirstlane(tid >> 6), lane = tid & 63, wr = wid >> 2, wc = wid & 3, fr = lane & 15, fq = lane >> 4;
    const int K = g.K, nt = K / BK;
    unsigned voffA[2], voffB[2];
#pragma unroll
    for (int i = 0; i < 2; ++i) { int R, C; stage_rc(tid * 16 + i * 8192, R, C); const int Rb = Epi::PERM ? ((R & ~31) + perm32(R & 31)) : R;
        voffA[i] = (unsigned)(R * K + C) * 2u; voffB[i] = (unsigned)(Rb * K + C) * 2u; }
    const size_t kstep = (size_t)(BK * 2);
    const size_t hstep = (size_t)HALF * K * 2;
    const size_t tstep = 2 * hstep;
    const unsigned ldsw = (unsigned)wid * 1024u;
    const int aoff = lds_byte(wr * 64 + fr, fq * 8), boff = lds_byte(wc * 32 + fr, fq * 8);
#define PG8_SA(b, h) (((b) * 2 + (h)) * HTB)
#define PG8_SB(b, h) ((4 + (b) * 2 + (h)) * HTB)
#define PG8_STAGE(bufoff, gbase, voff) do { _Pragma("unroll") for (int _i = 0; _i < 2; ++_i) \
        __builtin_amdgcn_global_load_lds((const unsigned*)((const char*)(gbase) + (voff)[_i]), (PG8_LAS unsigned*)(lds + (bufoff) + ldsw + _i * 8192), 16, 0, 0); } while (0)
#define PG8_LDA(dst, b, h) do { _Pragma("unroll") for (int m = 0; m < 4; ++m) _Pragma("unroll") for (int k = 0; k < 2; ++k) dst[m][k] = *(const PG8_LAS bf16x8*)(lds + PG8_SA(b, h) + aoff + m * 2048 + k * 1024); } while (0)
#define PG8_LDB(dst, b, h) do { _Pragma("unroll") for (int n = 0; n < 2; ++n) _Pragma("unroll") for (int k = 0; k < 2; ++k) dst[n][k] = *(const PG8_LAS bf16x8*)(lds + PG8_SB(b, h) + boff + n * 2048 + k * 1024); } while (0)
#define PG8_MMA(ai, bj, At, Bt) do { __builtin_amdgcn_s_setprio(1); _Pragma("unroll") for (int m = 0; m < 4; ++m) _Pragma("unroll") for (int n = 0; n < 2; ++n) _Pragma("unroll") for (int k = 0; k < 2; ++k) \
        acc[ai][bj][m][n] = __builtin_amdgcn_mfma_f32_16x16x32_bf16(Bt[n][k], At[m][k], acc[ai][bj][m][n], 0, 0, 0); __builtin_amdgcn_s_setprio(0); } while (0)
#define PG8_WAIT_V(n) asm volatile("s_waitcnt vmcnt(" #n ")" ::: "memory")
#define PG8_WAIT_L(n) asm volatile("s_waitcnt lgkmcnt(" #n ")" ::: "memory")
#define PG8_BAR __builtin_amdgcn_s_barrier()
#define PG8_SCHED __builtin_amdgcn_sched_barrier(0)
    Unit cur, nxt; int ui = 0;
    if (!S.next(0, cur)) return;
    f32x4 acc[2][2][4][2];
#pragma unroll
    for (int a = 0; a < 2; ++a)
#pragma unroll
        for (int b = 0; b < 2; ++b)
#pragma unroll
            for (int m = 0; m < 4; ++m)
#pragma unroll
                for (int n = 0; n < 2; ++n) acc[a][b][m][n] = (f32x4){0.f, 0.f, 0.f, 0.f};
    bf16x8 At[4][2], B0[2][2], B1[2][2];
    const char* cA = (const char*)g.A + (size_t)cur.pm * tstep; const char* cB = (const char*)g.Bt + (size_t)cur.pn * tstep;
    S.a_ready(cur);
    if constexpr (SP2) {
        PG8_STAGE(PG8_SB(0, 0), cB, voffB); PG8_STAGE(PG8_SB(0, 1), cB + hstep, voffB); PG8_STAGE(PG8_SA(0, 0), cA, voffA); PG8_STAGE(PG8_SA(0, 1), cA + hstep, voffA);
        if (wr == 1) PG8_BAR;
        PG8_WAIT_V(2); PG8_BAR;
        PG8_STAGE(PG8_SB(1, 0), cB + kstep, voffB); PG8_STAGE(PG8_SA(1, 0), cA + kstep, voffA); PG8_STAGE(PG8_SB(1, 1), cB + hstep + kstep, voffB);
        PG8_WAIT_V(6); PG8_BAR;
    } else {
        PG8_STAGE(PG8_SB(0, 0), cB, voffB); PG8_STAGE(PG8_SA(0, 0), cA, voffA); PG8_STAGE(PG8_SB(0, 1), cB + hstep, voffB); PG8_STAGE(PG8_SA(0, 1), cA + hstep, voffA);
        if (wr == 1) PG8_BAR;
        PG8_WAIT_V(4); PG8_BAR;
        PG8_STAGE(PG8_SB(1, 0), cB + kstep, voffB); PG8_STAGE(PG8_SA(1, 0), cA + kstep, voffA); PG8_STAGE(PG8_SB(1, 1), cB + hstep + kstep, voffB);
        PG8_WAIT_V(6); PG8_BAR;
    }
    for (;;) {
        const bool has_next = S.next(ui + 1, nxt);
        const char* nA = has_next ? (const char*)g.A + (size_t)nxt.pm * tstep : cA; const char* nB = has_next ? (const char*)g.Bt + (size_t)nxt.pn * tstep : cB;
        for (int t = 0; t < nt; t += 2) {
            const bool last = (t == nt - 2);
            const char* a1 = cA + (size_t)(t + 1) * kstep;
            const char* a2 = last ? nA : cA + (size_t)(t + 2) * kstep; const char* b2 = last ? nB : cB + (size_t)(t + 2) * kstep;
            const char* a3 = a2 + kstep; const char* b3 = b2 + kstep;
            if (last && has_next) S.a_ready(nxt);
            if constexpr (SP2) {
            PG8_LDB(B0, 0, 0); PG8_LDB(B1, 0, 1); PG8_SCHED; PG8_LDA(At, 0, 0); PG8_STAGE(PG8_SA(1, 1), a1 + hstep, voffA);
            PG8_WAIT_V(8); PG8_WAIT_L(0); PG8_BAR; PG8_MMA(0, 0, At, B0); PG8_MMA(0, 1, At, B1); PG8_BAR; PG8_SCHED;
            PG8_LDA(At, 0, 1); PG8_STAGE(PG8_SB(0, 0), b2, voffB); PG8_STAGE(PG8_SB(0, 1), b2 + hstep, voffB); PG8_STAGE(PG8_SA(0, 0), a2, voffA);
            PG8_WAIT_V(8); PG8_WAIT_L(0); PG8_BAR; PG8_MMA(1, 0, At, B0); PG8_MMA(1, 1, At, B1); PG8_BAR; PG8_SCHED;
            PG8_LDB(B0, 1, 0); PG8_LDB(B1, 1, 1); PG8_SCHED; PG8_LDA(At, 1, 0); PG8_STAGE(PG8_SA(0, 1), a2 + hstep, voffA);
            PG8_WAIT_V(8); PG8_WAIT_L(0); PG8_BAR; PG8_MMA(0, 0, At, B0); PG8_MMA(0, 1, At, B1); PG8_BAR; PG8_SCHED;
            PG8_LDA(At, 1, 1); PG8_STAGE(PG8_SB(1, 0), b3, voffB); PG8_STAGE(PG8_SB(1, 1), b3 + hstep, voffB); PG8_STAGE(PG8_SA(1, 0), a3, voffA);
            PG8_WAIT_V(8); PG8_WAIT_L(0); PG8_BAR; PG8_MMA(1, 0, At, B0); PG8_MMA(1, 1, At, B1); PG8_BAR; PG8_SCHED;
            } else {
            PG8_LDB(B0, 0, 0); PG8_SCHED; PG8_LDA(At, 0, 0); PG8_STAGE(PG8_SA(1, 1), a1 + hstep, voffA);
            PG8_WAIT_L(8); PG8_BAR; PG8_WAIT_L(0); PG8_MMA(0, 0, At, B0); PG8_BAR; PG8_SCHED;
            PG8_LDB(B1, 0, 1); PG8_STAGE(PG8_SB(0, 0), b2, voffB);
            PG8_BAR; PG8_WAIT_L(0); PG8_MMA(0, 1, At, B1); PG8_BAR;
            PG8_LDA(At, 0, 1); PG8_STAGE(PG8_SA(0, 0), a2, voffA);
            PG8_BAR; PG8_WAIT_L(0); PG8_MMA(1, 0, At, B0); PG8_BAR; PG8_SCHED;
            PG8_STAGE(PG8_SB(0, 1), b2 + hstep, voffB);
            PG8_WAIT_V(6); PG8_BAR; PG8_MMA(1, 1, At, B1); PG8_BAR;
            PG8_LDB(B0, 1, 0); PG8_SCHED; PG8_LDA(At, 1, 0); PG8_STAGE(PG8_SA(0, 1), a2 + hstep, voffA);
            PG8_WAIT_L(8); PG8_BAR; PG8_WAIT_L(0); PG8_MMA(0, 0, At, B0); PG8_BAR; PG8_SCHED;
            PG8_LDB(B1, 1, 1); PG8_STAGE(PG8_SB(1, 0), b3, voffB);
            PG8_BAR; PG8_WAIT_L(0); PG8_MMA(0, 1, At, B1); PG8_BAR;
            PG8_LDA(At, 1, 1); PG8_STAGE(PG8_SA(1, 0), a3, voffA);
            PG8_BAR; PG8_WAIT_L(0); PG8_MMA(1, 0, At, B0); PG8_BAR; PG8_SCHED;
            PG8_STAGE(PG8_SB(1, 1), b3 + hstep, voffB);
            PG8_WAIT_V(6); PG8_BAR; PG8_MMA(1, 1, At, B1); PG8_BAR;
            }
        }
        if constexpr (ALIGN_EPI) { if (wr == 0) PG8_BAR; }
        if constexpr (!Epi::AFTER_DRAIN) { E(acc, cur, wr, wc, fr, fq); S.done(cur); }
        if (!has_next) break;
#pragma unroll
        for (int a = 0; a < 2; ++a)
#pragma unroll
            for (int b = 0; b < 2; ++b)
#pragma unroll
                for (int m = 0; m < 4; ++m)
#pragma unroll
                    for (int n = 0; n < 2; ++n) acc[a][b][m][n] = (f32x4){0.f, 0.f, 0.f, 0.f};
        cur = nxt; cA = nA; cB = nB; ++ui;
        if constexpr (ALIGN_EPI) { if (wr == 1) PG8_BAR; }
    }
    PG8_WAIT_V(0);
    if constexpr (!ALIGN_EPI) { if (wr == 0) PG8_BAR; }
    PG8_BAR;
    if constexpr (Epi::AFTER_DRAIN) { E.fused(acc, cur, wr, wc, fr, fq, lds, wid, lane); S.done(cur); }
#undef PG8_SA
#undef PG8_SB
#undef PG8_STAGE
#undef PG8_LDA
#undef PG8_LDB
#undef PG8_MMA
#undef PG8_WAIT_V
#undef PG8_WAIT_L
#undef PG8_BAR
#undef PG8_SCHED
}
}
namespace att {
typedef unsigned short bf16_t;
typedef short bf16x8 __attribute__((ext_vector_type(8)));
typedef short s16x4 __attribute__((ext_vector_type(4)));
typedef short v4i16_t __attribute__((ext_vector_type(4)));
typedef float f32x16 __attribute__((ext_vector_type(16)));
typedef unsigned u32x4 __attribute__((ext_vector_type(4)));
typedef unsigned u32x2 __attribute__((ext_vector_type(2)));
#define ATT_LAS __attribute__((address_space(3)))
#define DI __device__ __forceinline__
constexpr int SEQ = 8192, LDQ = 3840;
constexpr int QA = 0, KA = 768, VA = 1536, QB = 2304, KB = 2816, VB = 3328;
constexpr int VROW = 192;
constexpr int VL_BYTES = 32 * VROW;
constexpr float LOG2E = 1.4426950408889634f;
#define MFMA32(a, b, c) __builtin_amdgcn_mfma_f32_32x32x16_bf16((a), (b), (c), 0, 0, 0)
DI int crow(int i, int h) { return (i & 3) + 8 * (i >> 2) + 4 * h; }
DI unsigned cvtpk(float lo, float hi) { typedef float f2_t __attribute__((ext_vector_type(2))); typedef __bf16 b2_t __attribute__((ext_vector_type(2))); f2_t v = {lo, hi}; b2_t b = __builtin_convertvector(v, b2_t); return __builtin_bit_cast(unsigned, b); }
DI s16x4 vtr(ATT_LAS const char* p) { return __builtin_bit_cast(s16x4, __builtin_amdgcn_ds_read_tr16_b64_v4i16((ATT_LAS v4i16_t*)p)); }
DI void swap32(float v, float& x0, float& x1) { float a = v, b = v; asm volatile("s_nop 1\n\tv_permlane32_swap_b32_e32 %0, %1\n\ts_nop 1" : "+v"(a), "+v"(b)); x0 = a; x1 = b; }
DI float swap_max(float v) { float x0, x1; swap32(v, x0, x1); return __builtin_fmaxf(x0, x1); }
DI float swap_sum(float v) { float x0, x1; swap32(v, x0, x1); return x0 + x1; }
DI void stage_v(ATT_LAS char* vl, int lane, const u32x4 (&vr)[4]) {
#pragma unroll
    for (int i = 0; i < 4; ++i) *(ATT_LAS u32x4*)(vl + ((lane >> 3) + 8 * i) * VROW + (lane & 7) * 16) = vr[i];
}
DI void pv_step(f32x16& o0, f32x16& o1, ATT_LAS const char* vl, int lane, const float (&a)[16]) {
    const int hi = lane >> 5, q = (lane & 15) >> 2, p = lane & 3, blk = (lane >> 4) & 1;
    ATT_LAS const char* base = vl + (4 * hi + q) * VROW + blk * 32 + p * 8;
#pragma unroll
    for (int s = 0; s < 2; ++s) {
        u32x4 pw; pw.x = cvtpk(a[8 * s + 0], a[8 * s + 1]); pw.y = cvtpk(a[8 * s + 2], a[8 * s + 3]); pw.z = cvtpk(a[8 * s + 4], a[8 * s + 5]); pw.w = cvtpk(a[8 * s + 6], a[8 * s + 7]);
        const bf16x8 pf = __builtin_bit_cast(bf16x8, pw);
        { const s16x4 lo = vtr(base + (16 * s) * VROW), hh = vtr(base + (16 * s + 8) * VROW);
          const bf16x8 vt = __builtin_shufflevector(lo, hh, 0, 1, 2, 3, 4, 5, 6, 7); o0 = MFMA32(vt, pf, o0); }
        { const s16x4 lo = vtr(base + (16 * s) * VROW + 64), hh = vtr(base + (16 * s + 8) * VROW + 64);
          const bf16x8 vt = __builtin_shufflevector(lo, hh, 0, 1, 2, 3, 4, 5, 6, 7); o1 = MFMA32(vt, pf, o1); }
    }
}
DI void store_o(bf16_t* orow, const f32x16& o0, const f32x16& o1, int hi, float sc) {
#pragma unroll
    for (int g = 0; g < 4; ++g) {
        u32x2 w0, w1; w0.x = cvtpk(o0[4 * g] * sc, o0[4 * g + 1] * sc); w0.y = cvtpk(o0[4 * g + 2] * sc, o0[4 * g + 3] * sc);
        w1.x = cvtpk(o1[4 * g] * sc, o1[4 * g + 1] * sc); w1.y = cvtpk(o1[4 * g + 2] * sc, o1[4 * g + 3] * sc);
        *(u32x2*)(orow + 8 * g + 4 * hi) = w0; *(u32x2*)(orow + 32 + 8 * g + 4 * hi) = w1;
    }
}

template <bool EARLY_EXIT>
DI void sb_unit(const bf16_t* __restrict__ qkv, bf16_t* __restrict__ ob, int b, int h, int qblk, ATT_LAS char* vl, int lane) {
    const int r32 = lane & 31, hi = lane >> 5;
    const size_t rowb = (size_t)b * SEQ; const int q0 = qblk * 32;
    const bf16_t* Qp = qkv + (rowb + q0 + r32) * LDQ + QB + h * 64 + 8 * hi;
    bf16x8 qf[4];
#pragma unroll
    for (int d0 = 0; d0 < 4; ++d0) qf[d0] = *(const bf16x8*)(Qp + 16 * d0);
    const bf16_t* Kp = qkv + (rowb + r32) * LDQ + KB + h * 64 + 8 * hi;
    const bf16_t* Vp = qkv + (rowb + (lane >> 3)) * LDQ + VB + h * 64 + (lane & 7) * 8;
    f32x16 o0, o1;
#pragma unroll
    for (int i = 0; i < 16; ++i) { o0[i] = 0.f; o1[i] = 0.f; }
    float carry = 1.f;
    bf16x8 kf[4]; u32x4 vr[4];
    { const size_t ko = (size_t)q0 * LDQ;
#pragma unroll
      for (int d0 = 0; d0 < 4; ++d0) kf[d0] = *(const bf16x8*)(Kp + ko + 16 * d0);
#pragma unroll
      for (int i = 0; i < 4; ++i) vr[i] = *(const u32x4*)(Vp + ko + (size_t)(8 * i) * LDQ); }
#pragma unroll 1
    for (int kt = qblk; kt >= 0; --kt) {
        bf16x8 kn[4]; u32x4 vn[4];
        { const int ktn = kt > 0 ? kt - 1 : 0; const size_t ko = (size_t)(ktn * 32) * LDQ;
#pragma unroll
          for (int d0 = 0; d0 < 4; ++d0) kn[d0] = *(const bf16x8*)(Kp + ko + 16 * d0);
#pragma unroll
          for (int i = 0; i < 4; ++i) vn[i] = *(const u32x4*)(Vp + ko + (size_t)(8 * i) * LDQ); }
        stage_v(vl, lane, vr);
        f32x16 s;
#pragma unroll
        for (int i = 0; i < 16; ++i) s[i] = 0.f;
#pragma unroll
        for (int d0 = 0; d0 < 4; ++d0) s = MFMA32(kf[d0], qf[d0], s);
        if (kt == qblk) {
#pragma unroll
            for (int i = 0; i < 16; ++i) if (crow(i, hi) >= r32) s[i] = -__builtin_inff();
        }
        float r[16], a[16], T[4], To[4], PT[4];
#pragma unroll
        for (int i = 0; i < 16; ++i) r[i] = __builtin_amdgcn_rcpf(1.f + __builtin_amdgcn_exp2f(s[i]));
#pragma unroll
        for (int g = 0; g < 4; ++g) {
            const float c2 = r[4 * g + 3], c1 = r[4 * g + 2] * c2, c0 = r[4 * g + 1] * c1;
            T[g] = r[4 * g] * c0;
            a[4 * g + 3] = (1.f - r[4 * g + 3]);
            a[4 * g + 2] = (1.f - r[4 * g + 2]) * c2;
            a[4 * g + 1] = (1.f - r[4 * g + 1]) * c1;
            a[4 * g + 0] = (1.f - r[4 * g + 0]) * c0;
            float x0, x1; swap32(T[g], x0, x1);
            const float oth = (__builtin_bit_cast(unsigned, x0) == __builtin_bit_cast(unsigned, T[g])) ? x1 : x0;
            To[g] = hi ? 1.f : oth;
            PT[g] = x0 * x1;
        }
        const float S3 = carry, S2 = S3 * PT[3], S1 = S2 * PT[2], S0 = S1 * PT[1];
        const float off3 = S3 * To[3], off2 = S2 * To[2], off1 = S1 * To[1], off0 = S0 * To[0];
        carry = S0 * PT[0];
#pragma unroll
        for (int j = 0; j < 4; ++j) { a[j] *= off0; a[4 + j] *= off1; a[8 + j] *= off2; a[12 + j] *= off3; }
        pv_step(o0, o1, vl, lane, a);
        if (EARLY_EXIT) { if (__builtin_amdgcn_ballot_w64(carry != 0.f) == 0ull) break; }
#pragma unroll
        for (int d0 = 0; d0 < 4; ++d0) kf[d0] = kn[d0];
#pragma unroll
        for (int i = 0; i < 4; ++i) vr[i] = vn[i];
    }
    store_o(ob + (rowb + q0 + r32) * 512 + h * 64, o0, o1, hi, 1.f);
}

DI void dil_unit(const bf16_t* __restrict__ qkv, bf16_t* __restrict__ oa, int b, int j, int t0, ATT_LAS char* vl, int lane) {
    const int r32 = lane & 31, hi = lane >> 5;
    const size_t rowb = (size_t)b * SEQ;
    f32x16 o0, o1;
#pragma unroll
    for (int i = 0; i < 16; ++i) { o0[i] = 0.f; o1[i] = 0.f; }
    float m = -1e30f, l = 0.f;
#pragma unroll 1
    for (int g = 0; g < 3; ++g) {
        const int sh = 2 * g, d = 1 << sh, hg = 4 * g + j, NT = (g == 0) ? 20 : (g == 1 ? 8 : 5);
        const float slope2 = exp2f(-8.f * (float)(hg + 1) / 12.f) * (float)d * LOG2E;
        const int c = ((16 * r32) >> sh) + 128;
        const int nmin = 128 - (t0 >> sh);
        const int ubase = t0 - 128 * d;
        const bf16_t* Qp = qkv + (rowb + t0 + 16 * r32) * LDQ + QA + hg * 64 + 8 * hi;
        bf16x8 qf[4];
#pragma unroll
        for (int d0 = 0; d0 < 4; ++d0) qf[d0] = *(const bf16x8*)(Qp + 16 * d0);
        const bf16_t* Kh = qkv + rowb * LDQ + KA + hg * 64 + 8 * hi;
        const bf16_t* Vh = qkv + rowb * LDQ + VA + hg * 64 + (lane & 7) * 8;
        int tile = 0;
        while ((tile + 1) * 32 <= nmin) ++tile;
        bf16x8 kf[4]; u32x4 vr[4];
#define DIL_LOAD(KF, VR, TL) do { const int n0_ = 32 * (TL); int uk = ubase + d * (n0_ + r32); uk = uk < 0 ? 0 : (uk > SEQ - 1 ? SEQ - 1 : uk); \
            _Pragma("unroll") for (int d0 = 0; d0 < 4; ++d0) KF[d0] = *(const bf16x8*)(Kh + (size_t)uk * LDQ + 16 * d0); \
            _Pragma("unroll") for (int i = 0; i < 4; ++i) { int uv = ubase + d * (n0_ + (lane >> 3) + 8 * i); uv = uv < 0 ? 0 : (uv > SEQ - 1 ? SEQ - 1 : uv); VR[i] = *(const u32x4*)(Vh + (size_t)uv * LDQ); } } while (0)
        DIL_LOAD(kf, vr, tile);
#pragma unroll 1
        for (; tile < NT; ++tile) {
            bf16x8 kn[4]; u32x4 vn[4];
            { const int tn = tile + 1 < NT ? tile + 1 : tile; DIL_LOAD(kn, vn, tn); }
            stage_v(vl, lane, vr);
            f32x16 s;
#pragma unroll
            for (int i = 0; i < 16; ++i) s[i] = 0.f;
#pragma unroll
            for (int d0 = 0; d0 < 4; ++d0) s = MFMA32(kf[d0], qf[d0], s);
            const int n0 = 32 * tile;
            float lg[16]; float mx = -1e30f;
#pragma unroll
            for (int i = 0; i < 16; ++i) { const int n = n0 + crow(i, hi), step = c - n; const bool valid = ((unsigned)step <= 128u) && (n >= nmin);
                lg[i] = valid ? (s[i] - slope2 * (float)step) : -1e30f; mx = __builtin_fmaxf(mx, lg[i]); }
            mx = swap_max(mx);
            const float mn = __builtin_fmaxf(m, mx), alpha = __builtin_amdgcn_exp2f(m - mn);
            m = mn;
            float ps = 0.f;
#pragma unroll
            for (int i = 0; i < 16; ++i) { lg[i] = __builtin_amdgcn_exp2f(lg[i] - mn); ps += lg[i]; }
            l = l * alpha + ps;
#pragma unroll
            for (int i = 0; i < 16; ++i) { o0[i] *= alpha; o1[i] *= alpha; }
            pv_step(o0, o1, vl, lane, lg);
#pragma unroll
            for (int d0 = 0; d0 < 4; ++d0) kf[d0] = kn[d0];
#pragma unroll
            for (int i = 0; i < 4; ++i) vr[i] = vn[i];
        }
#undef DIL_LOAD
    }
    l = swap_sum(l);
    store_o(oa + (rowb + t0 + 16 * r32) * 256 + j * 64, o0, o1, hi, 1.f / l);
}
#undef DI
}
namespace cg = cooperative_groups;
#define LAS __attribute__((address_space(3)))
typedef unsigned short bf16;
typedef unsigned v4u __attribute__((ext_vector_type(4)));
typedef float f32x4 __attribute__((ext_vector_type(4)));
constexpr int NWAVES = 8;
constexpr int M = 16384, D = 1024, FF = 4096, NPROJ = 5888;
constexpr float RMS_EPS = 1e-6f;
#ifndef SB_EARLY_EXIT
#define SB_EARLY_EXIT true
#endif
constexpr size_t MiB = 1u << 20;
constexpr size_t WS_WIN = 1 * MiB, WS_WUD = 13 * MiB, WS_WUS = 14 * MiB, WS_WO = 15 * MiB, WS_W1 = 17 * MiB, WS_W2 = 25 * MiB;
constexpr size_t WS_R1 = 33 * MiB;
constexpr size_t WS_OA = WS_R1, WS_OB = WS_R1 + 8 * MiB;
constexpr size_t WS_QKV = 65 * MiB;
constexpr size_t WS_G = 185 * MiB;
constexpr size_t WS_END = 249 * MiB;
constexpr int LDS_BYTES = 147456;
static_assert(NWAVES * att::VL_BYTES <= pg8::STAGE_BYTES && pg8::STAGE_BYTES <= LDS_BYTES, "LDS map");

__device__ __forceinline__ float wave_sum(float v) {
#pragma unroll
    for (int o = 1; o < 64; o <<= 1) v += __shfl_xor(v, o);
    return v;
}
__device__ __forceinline__ unsigned f2bf(float f) { unsigned u = __builtin_bit_cast(unsigned, f); return (u + 0x7fffu + ((u >> 16) & 1u)) >> 16; }
__device__ __forceinline__ unsigned pk2(float lo, float hi) { return f2bf(lo) | (f2bf(hi) << 16); }
__device__ __forceinline__ void p0_transpose_item(const float* W, int K, int N, bf16* WT, LAS float* scr, int item, int lane) {
    const int nblk = N / 32, kb = item / nblk, nb = item % nblk, k0 = 64 * kb, n0 = 32 * nb;
#pragma unroll 8
    for (int i = 0; i < 32; ++i) { const int kk = 2 * i + (lane >> 5); scr[kk * 33 + (lane & 31)] = W[(size_t)(k0 + kk) * N + n0 + (lane & 31)]; }
    asm volatile("s_waitcnt lgkmcnt(0)" ::: "memory");
    const int c = lane & 7;
#pragma unroll
    for (int j = 0; j < 4; ++j) { const int n = (lane >> 3) + 8 * j; const LAS float* s = scr + (8 * c) * 33 + n;
        v4u o; o.x = pk2(s[0 * 33], s[1 * 33]); o.y = pk2(s[2 * 33], s[3 * 33]); o.z = pk2(s[4 * 33], s[5 * 33]); o.w = pk2(s[6 * 33], s[7 * 33]);
        *(v4u*)(WT + (size_t)(n0 + n) * K + k0 + 8 * c) = o; }
    asm volatile("s_waitcnt lgkmcnt(0)" ::: "memory");
}
__device__ __forceinline__ void rms_row_to_bf16(const float* xrow, const float* g, bf16* orow, int lane) {
    const f32x4* xr = (const f32x4*)xrow + lane; const f32x4* gr = (const f32x4*)g + lane;
    f32x4 v[4]; float s = 0.f;
#pragma unroll
    for (int j = 0; j < 4; ++j) { v[j] = xr[64 * j]; s += (v[j].x * v[j].x + v[j].y * v[j].y) + (v[j].z * v[j].z + v[j].w * v[j].w); }
    const float rstd = 1.f / sqrtf(wave_sum(s) * (1.f / D) + RMS_EPS);
    unsigned long long* o8 = (unsigned long long*)orow + lane;
#pragma unroll
    for (int j = 0; j < 4; ++j) { const f32x4 gv = gr[64 * j]; o8[64 * j] = (unsigned long long)pk2(v[j].x * rstd * gv.x, v[j].y * rstd * gv.y) | ((unsigned long long)pk2(v[j].z * rstd * gv.z, v[j].w * rstd * gv.w) << 32); }
}
__device__ __forceinline__ void rms_row_inplace(float* xrow, const float* g, int lane) {
    f32x4* xr = (f32x4*)xrow + lane; const f32x4* gr = (const f32x4*)g + lane;
    f32x4 v[4]; float s = 0.f;
#pragma unroll
    for (int j = 0; j < 4; ++j) { v[j] = xr[64 * j]; s += (v[j].x * v[j].x + v[j].y * v[j].y) + (v[j].z * v[j].z + v[j].w * v[j].w); }
    const float rstd = 1.f / sqrtf(wave_sum(s) * (1.f / D) + RMS_EPS);
#pragma unroll
    for (int j = 0; j < 4; ++j) { const f32x4 gv = gr[64 * j]; xr[64 * j] = v[j] * rstd * gv; }
}

struct Args { const float* x; const float* g_mix; const float* w_in; const float* b_gate; const float* w_up_dil; const float* w_up_sb; const float* w_out;
              const float* g_mlp; const float* w_mlp_in; const float* w_mlp_out; const float* g_final; float* out; unsigned char* ws; int ph_lo, ph_hi; };
constexpr int N_PHASES = 9;

__global__ void __launch_bounds__(NWAVES * 64, 2) fwd_megakernel(Args a) {
    extern __shared__ __attribute__((aligned(16))) unsigned char lds_raw[];
    LAS unsigned char* lds = (LAS unsigned char*)lds_raw;
    const int tid = threadIdx.x, lane = tid & 63, wave = __builtin_amdgcn_readfirstlane(tid >> 6);
    const int G = gridDim.x, gw = blockIdx.x * NWAVES + wave, NGW = G * NWAVES;
    unsigned char* ws = a.ws;
    bf16* Win_t = (bf16*)(ws + WS_WIN); bf16* Wud_t = (bf16*)(ws + WS_WUD); bf16* Wus_t = (bf16*)(ws + WS_WUS); bf16* Wo_t = (bf16*)(ws + WS_WO);
    bf16* W1_t = (bf16*)(ws + WS_W1); bf16* W2_t = (bf16*)(ws + WS_W2);
    bf16* R1 = (bf16*)(ws + WS_R1); bf16* OA = (bf16*)(ws + WS_OA); bf16* OB = (bf16*)(ws + WS_OB);
    bf16* QKV = (bf16*)(ws + WS_QKV); bf16* GATES = (bf16*)(ws + WS_G);
    bf16* MERGED = QKV; bf16* UB = QKV;
    const int lo = a.ph_lo, hi = a.ph_hi;
#ifndef DBG_STOP
#define DBG_STOP 99
#endif
#define IN(k) (lo <= (k) && (k) < hi && (k) <= DBG_STOP)
#define SEAM(k) do { if (IN(k) && IN((k) + 1)) cg::this_grid().sync(); } while (0)

    if (IN(0)) {
        LAS float* scr = (LAS float*)(lds + wave * 16384);
        constexpr int I_IN = (D / 64) * (NPROJ / 32), I_UD = (256 / 64) * (D / 32), I_US = (512 / 64) * (D / 32), I_O = (D / 64) * (D / 32), I_1 = (D / 64) * (FF / 32), I_2 = (FF / 64) * (D / 32);
        constexpr int NITEMS = I_IN + I_UD + I_US + I_O + I_1 + I_2;
        for (int it = gw; it < NITEMS; it += NGW) {
            int r = it;
            if (r < I_IN) { p0_transpose_item(a.w_in, D, NPROJ, Win_t, scr, r, lane); continue; } r -= I_IN;
            if (r < I_UD) { p0_transpose_item(a.w_up_dil, 256, D, Wud_t, scr, r, lane); continue; } r -= I_UD;
            if (r < I_US) { p0_transpose_item(a.w_up_sb, 512, D, Wus_t, scr, r, lane); continue; } r -= I_US;
            if (r < I_O) { p0_transpose_item(a.w_out, D, D, Wo_t, scr, r, lane); continue; } r -= I_O;
            if (r < I_1) { p0_transpose_item(a.w_mlp_in, D, FF, W1_t, scr, r, lane); continue; } r -= I_1;
            p0_transpose_item(a.w_mlp_out, FF, D, W2_t, scr, r, lane);
        }
        for (int m = gw; m < M; m += NGW) rms_row_to_bf16(a.x + (size_t)m * D, a.g_mix, R1 + (size_t)m * D, lane);
        asm volatile("s_waitcnt vmcnt(0) lgkmcnt(0)" ::: "memory"); __syncthreads();
    }
    SEAM(0);
    if (IN(1)) {
        pg8::Gemm g{R1, Win_t, M, NPROJ, D}; pg8::StaticOrder S; S.init(M, NPROJ, G, (int)blockIdx.x);
        pg8::EpiProj E{QKV, GATES, a.b_gate};
        pg8::gemm_phase<pg8::EpiProj, pg8::StaticOrder, true, true>(lds, g, S, E);
    }
    SEAM(1);
    if (IN(2)) {
        ATT_LAS char* vl = (ATT_LAS char*)(lds + wave * att::VL_BYTES);
        for (int id = gw; id < 2048; id += NGW) att::dil_unit(QKV, OA, id >> 10, (id >> 4) & 3, 512 * ((id >> 6) & 15) + (id & 15), vl, lane);
        for (int id = gw; id < 4096; id += NGW) att::sb_unit<SB_EARLY_EXIT>(QKV, OB, id >> 11, (id >> 8) & 7, id & 255, vl, lane);
        asm volatile("s_waitcnt vmcnt(0) lgkmcnt(0)" ::: "memory"); __syncthreads();
    }
    SEAM(2);
    if (IN(3)) {
        pg8::StaticOrder S; S.init(M, D, G, (int)blockIdx.x);
        { pg8::Gemm g{OB, Wus_t, M, D, 512}; pg8::EpiUp<true> E{MERGED, GATES, 1024};
          pg8::gemm_phase<pg8::EpiUp<true>, pg8::StaticOrder, true, true>(lds, g, S, E); }
        { pg8::Gemm g{OA, Wud_t, M, D, 256}; pg8::EpiUp<false> E{MERGED, GATES, 0};
          pg8::gemm_phase<pg8::EpiUp<false>, pg8::StaticOrder, true, true>(lds, g, S, E); }
    }
    SEAM(3);
    if (IN(4)) {
        pg8::Gemm g{MERGED, Wo_t, M, D, D}; pg8::StaticOrder S; S.init(M, D, G, (int)blockIdx.x);
        pg8::EpiRes E{a.x, a.out};
        pg8::gemm_phase<pg8::EpiRes, pg8::StaticOrder, true, true>(lds, g, S, E);
    }
    SEAM(4);
    if (IN(5)) {
        for (int m = gw; m < M; m += NGW) rms_row_to_bf16(a.out + (size_t)m * D, a.g_mlp, R1 + (size_t)m * D, lane);
    }
    SEAM(5);
    if (IN(6)) {
        pg8::Gemm g{R1, W1_t, M, FF, D}; pg8::StaticOrder S; S.init(M, FF, G, (int)blockIdx.x);
        pg8::EpiRelu2 E{UB};
        pg8::gemm_phase<pg8::EpiRelu2, pg8::StaticOrder, true, true>(lds, g, S, E);
    }
    SEAM(6);
    if (IN(7)) {
        pg8::Gemm g{UB, W2_t, M, D, FF}; pg8::StaticOrder S; S.init(M, D, G, (int)blockIdx.x);
        pg8::EpiRes E{a.out, a.out};
        pg8::gemm_phase<pg8::EpiRes, pg8::StaticOrder, true, true>(lds, g, S, E);
    }
    SEAM(7);
    if (IN(8)) {
        for (int m = gw; m < M; m += NGW) rms_row_inplace(a.out + (size_t)m * D, a.g_final, lane);
    }
#if DBG_STOP < 99
    if (lo <= 8 && 8 < hi) {
        const bf16* src = (const bf16*)(ws + DBG_OFF); const size_t n = (size_t)DBG_N;
        for (size_t i = (size_t)blockIdx.x * 512 + tid; i < (size_t)M * D; i += (size_t)G * 512) { float acc = 0.f; for (size_t j = i; j < n; j += (size_t)M * D) acc += __builtin_bit_cast(float, (unsigned)src[j] << 16); a.out[i] = acc; }
    }
#endif
#undef IN
#undef SEAM
}

#ifndef MK_N_LAUNCHES
#define MK_N_LAUNCHES 1
#endif
extern "C" void kernel_launch(void* const* d_in, const int* in_sizes, int n_in, void* d_out, int out_size, void* d_ws, size_t ws_size, hipStream_t stream) {
    static int grid = 0;
    if (grid == 0) {
        if (n_in != 11 || in_sizes[0] != M * D || out_size != M * D || ws_size < WS_END) { fprintf(stderr, "kernel_launch: unexpected shapes (n_in %d, in0 %d, out %d, ws %zu); nothing launched\n", n_in, n_in > 0 ? in_sizes[0] : -1, out_size, ws_size); grid = -1; return; }
        int dev = 0, cus = 0, per_cu = 0;
        if (hipGetDevice(&dev) != hipSuccess || hipDeviceGetAttribute(&cus, hipDeviceAttributeMultiprocessorCount, dev) != hipSuccess) { grid = -1; return; }
        if (hipFuncSetAttribute((const void*)fwd_megakernel, hipFuncAttributeMaxDynamicSharedMemorySize, LDS_BYTES) != hipSuccess) { fprintf(stderr, "kernel_launch: hipFuncSetAttribute failed\n"); grid = -1; return; }
        if (hipOccupancyMaxActiveBlocksPerMultiprocessor(&per_cu, (const void*)fwd_megakernel, NWAVES * 64, LDS_BYTES) != hipSuccess || per_cu < 1) { fprintf(stderr, "kernel_launch: occupancy query says %d blocks per CU\n", per_cu); per_cu = 1; }
        (void)hipGetLastError();
        grid = cus * per_cu;
    }
    if (grid < 0) return;
    Args a{};
    a.x = (const float*)d_in[0]; a.g_mix = (const float*)d_in[1]; a.w_in = (const float*)d_in[2]; a.b_gate = (const float*)d_in[3];
    a.w_up_dil = (const float*)d_in[4]; a.w_up_sb = (const float*)d_in[5]; a.w_out = (const float*)d_in[6]; a.g_mlp = (const float*)d_in[7];
    a.w_mlp_in = (const float*)d_in[8]; a.w_mlp_out = (const float*)d_in[9]; a.g_final = (const float*)d_in[10];
    a.out = (float*)d_out; a.ws = (unsigned char*)d_ws;
#if MK_N_LAUNCHES == 1
    a.ph_lo = 0; a.ph_hi = N_PHASES;
    void* args[] = {&a};
    hipError_t e = hipLaunchCooperativeKernel((const void*)fwd_megakernel, dim3(grid), dim3(NWAVES * 64), args, LDS_BYTES, stream);
    if (e != hipSuccess) fprintf(stderr, "kernel_launch: cooperative launch failed: %s (grid %d)\n", hipGetErrorString(e), grid);
#else
    for (int p = 0; p < N_PHASES; ++p) { a.ph_lo = p; a.ph_hi = p + 1; hipLaunchKernelGGL(fwd_megakernel, dim3(grid), dim3(NWAVES * 64), LDS_BYTES, stream, a); }
#endif
}
```

```cpp
#include <hip/hip_cooperative_groups.h>
#include <hip/hip_runtime.h>
#include <cstdio>
#include <cstdint>
namespace pg8 {
#define PG8_LAS __attribute__((address_space(3)))
typedef unsigned short bf16_t;
typedef short bf16x8 __attribute__((ext_vector_type(8)));
typedef float f32x4 __attribute__((ext_vector_type(4)));
typedef unsigned u32x4 __attribute__((ext_vector_type(4)));
constexpr int BM = 256, BK = 64, HALF = 128, HTB = HALF * BK * 2  , STAGE_BYTES = 8 * HTB, NXCD = 8, WGM = 8;

__host__ __device__ __forceinline__ int lds_byte(int r, int c) { const int st = (r >> 4) * 2 + (c >> 5), rr = r & 15, cc = c & 31, ob = rr * 64 + cc * 2; return st * 1024 + (ob ^ (((ob >> 9) & 1) << 5)); }
__host__ __device__ __forceinline__ void stage_rc(int b, int& R, int& C) { const int st = b / 1024, sb = b % 1024, swz = sb ^ (((sb >> 9) & 1) << 5); R = (st >> 1) * 16 + swz / 64; C = (st & 1) * 32 + (swz % 64) / 2; }
__host__ __device__ __forceinline__ int perm32(int rho) { const int n = rho >> 4, i = rho & 15; return 8 * (i >> 2) + 4 * n + (i & 3); }

struct Unit { int pm, pn; };
struct Gemm { const bf16_t* A; const bf16_t* Bt; int M, N, K; };

struct StaticOrder {
    int nM, nN, nwg, G, c;
    __host__ __device__ void init(int M, int N, int G_, int c_) { nM = M / BM; nN = N / BM; nwg = nM * nN; G = G_; c = c_; }
    __host__ __device__ bool next(int i, Unit& u) const {
        const long L = (long)i * G + c; if (L >= nwg) return false;
        int wgid = (int)L; { const int q = nwg / NXCD, r = nwg % NXCD, xcd = wgid % NXCD, off = wgid / NXCD; wgid = (xcd < r ? xcd * (q + 1) : r * (q + 1) + (xcd - r) * q) + off; }
        const int nig = WGM * nN, gid = wgid / nig, fm = gid * WGM, gsz = (nM - fm) < WGM ? (nM - fm) : WGM;
        u.pm = fm + ((wgid % nig) % gsz); u.pn = (wgid % nig) / gsz; return true;
    }
    __device__ __forceinline__ void a_ready(const Unit&) const {}
    __device__ __forceinline__ void done(const Unit&) const {}
};


__device__ __forceinline__ unsigned cvt_pk_bf16(float lo, float hi) { typedef float f2_t __attribute__((ext_vector_type(2))); typedef __bf16 b2_t __attribute__((ext_vector_type(2))); f2_t v = {lo, hi}; b2_t b = __builtin_convertvector(v, b2_t); return __builtin_bit_cast(unsigned, b); }
__device__ __forceinline__ float bf_lo(unsigned w) { return __builtin_bit_cast(float, w << 16); }
__device__ __forceinline__ float bf_hi(unsigned w) { return __builtin_bit_cast(float, w & 0xffff0000u); }
__device__ __forceinline__ u32x4 pack8(f32x4 v0, f32x4 v1) { u32x4 w; w.x = cvt_pk_bf16(v0[0], v0[1]); w.y = cvt_pk_bf16(v0[2], v0[3]); w.z = cvt_pk_bf16(v1[0], v1[1]); w.w = cvt_pk_bf16(v1[2], v1[3]); return w; }
constexpr float QSCALE = 0.125f * 1.4426950408889634f;
constexpr int LD_QKV = 3840, LD_G = 2048;

struct EpiProj {
    static constexpr bool PERM = true, AFTER_DRAIN = false;
    bf16_t* qkv; bf16_t* gates; const float* bgate;
    __device__ __forceinline__ void operator()(const f32x4 (&acc)[2][2][4][2], const Unit& u, int wr, int wc, int fr, int fq) const {
        const int row0 = u.pm * BM + wr * 64 + fr, cw = wc * 32 + 8 * fq;
        if (u.pn < 15) {
            const float sc = (u.pn < 3 || u.pn == 9 || u.pn == 10) ? QSCALE : 1.f;
            bf16_t* base = qkv + u.pn * BM + cw;
#pragma unroll
            for (int ai = 0; ai < 2; ++ai)
#pragma unroll
                for (int m = 0; m < 4; ++m) { bf16_t* rowp = base + (size_t)(row0 + ai * HALF + m * 16) * LD_QKV;
#pragma unroll
                    for (int bj = 0; bj < 2; ++bj) *(u32x4*)(rowp + bj * HALF) = pack8(acc[ai][bj][m][0] * sc, acc[ai][bj][m][1] * sc); }
        } else {
            const int gc = (u.pn - 15) * BM + cw;
            f32x4 bv[2][2];
#pragma unroll
            for (int bj = 0; bj < 2; ++bj)
#pragma unroll
                for (int n = 0; n < 2; ++n) bv[bj][n] = *(const f32x4*)(bgate + gc + bj * HALF + 4 * n);
            bf16_t* base = gates + gc;
#pragma unroll
            for (int ai = 0; ai < 2; ++ai)
#pragma unroll
                for (int m = 0; m < 4; ++m) { bf16_t* rowp = base + (size_t)(row0 + ai * HALF + m * 16) * LD_G;
#pragma unroll
                    for (int bj = 0; bj < 2; ++bj) { f32x4 v[2];
#pragma unroll
                        for (int n = 0; n < 2; ++n) { const f32x4 z = acc[ai][bj][m][n] + bv[bj][n];
#pragma unroll
                            for (int e = 0; e < 4; ++e) v[n][e] = __builtin_amdgcn_rcpf(1.f + __builtin_amdgcn_exp2f(-1.4426950408889634f * z[e])); }
                        *(u32x4*)(rowp + bj * HALF) = pack8(v[0], v[1]); } }
        }
    }
};
template <bool FIRST> struct EpiUp {
    static constexpr bool PERM = true, AFTER_DRAIN = false;
    bf16_t* merged; const bf16_t* gates; int gofs;
    __device__ __forceinline__ void operator()(const f32x4 (&acc)[2][2][4][2], const Unit& u, int wr, int wc, int fr, int fq) const {
        const int row0 = u.pm * BM + wr * 64 + fr, col0 = u.pn * BM + wc * 32 + 8 * fq;
#pragma unroll
        for (int ai = 0; ai < 2; ++ai)
#pragma unroll
            for (int m = 0; m < 4; ++m) { const size_t row = (size_t)(row0 + ai * HALF + m * 16);
#pragma unroll
                for (int bj = 0; bj < 2; ++bj) { const int col = col0 + bj * HALF;
                    const u32x4 gw = *(const u32x4*)(gates + row * LD_G + gofs + col);
                    f32x4 v0 = acc[ai][bj][m][0], v1 = acc[ai][bj][m][1];
                    v0[0] *= bf_lo(gw.x); v0[1] *= bf_hi(gw.x); v0[2] *= bf_lo(gw.y); v0[3] *= bf_hi(gw.y);
                    v1[0] *= bf_lo(gw.z); v1[1] *= bf_hi(gw.z); v1[2] *= bf_lo(gw.w); v1[3] *= bf_hi(gw.w);
                    bf16_t* op = merged + row * 1024 + col;
                    if (!FIRST) { const u32x4 pw = *(const u32x4*)op;
                        v0[0] += bf_lo(pw.x); v0[1] += bf_hi(pw.x); v0[2] += bf_lo(pw.y); v0[3] += bf_hi(pw.y);
                        v1[0] += bf_lo(pw.z); v1[1] += bf_hi(pw.z); v1[2] += bf_lo(pw.w); v1[3] += bf_hi(pw.w); }
                    *(u32x4*)op = pack8(v0, v1); } }
    }
};
struct EpiRes {
    static constexpr bool PERM = true, AFTER_DRAIN = false;
    const float* base; float* out;
    __device__ __forceinline__ void operator()(const f32x4 (&acc)[2][2][4][2], const Unit& u, int wr, int wc, int fr, int fq) const {
        const int row0 = u.pm * BM + wr * 64 + fr, col0 = u.pn * BM + wc * 32 + 8 * fq;
#pragma unroll
        for (int ai = 0; ai < 2; ++ai)
#pragma unroll
            for (int m = 0; m < 4; ++m) { const size_t ro = (size_t)(row0 + ai * HALF + m * 16) * 1024 + col0;
#pragma unroll
                for (int bj = 0; bj < 2; ++bj)
#pragma unroll
                    for (int n = 0; n < 2; ++n) { const size_t off = ro + bj * HALF + 4 * n; *(f32x4*)(out + off) = *(const f32x4*)(base + off) + acc[ai][bj][m][n]; } }
    }
};
struct EpiRelu2 {
    static constexpr bool PERM = true, AFTER_DRAIN = false;
    bf16_t* O;
    __device__ __forceinline__ void operator()(const f32x4 (&acc)[2][2][4][2], const Unit& u, int wr, int wc, int fr, int fq) const {
        const int row0 = u.pm * BM + wr * 64 + fr, col0 = u.pn * BM + wc * 32 + 8 * fq;
#pragma unroll
        for (int ai = 0; ai < 2; ++ai)
#pragma unroll
            for (int m = 0; m < 4; ++m) { bf16_t* rowp = O + (size_t)(row0 + ai * HALF + m * 16) * 4096 + col0;
#pragma unroll
                for (int bj = 0; bj < 2; ++bj) { f32x4 v[2];
#pragma unroll
                    for (int n = 0; n < 2; ++n) { const f32x4 z = acc[ai][bj][m][n];
#pragma unroll
                        for (int e = 0; e < 4; ++e) { const float r = z[e] > 0.f ? z[e] : 0.f; v[n][e] = r * r; } }
                    *(u32x4*)(rowp + bj * HALF) = pack8(v[0], v[1]); } }
    }
};

template <class Epi, class Sched, bool ALIGN_EPI = false, bool SP2 = false>
__device__ __forceinline__ void gemm_phase(PG8_LAS unsigned char* lds, const Gemm g, const Sched& S, const Epi& E) {
    const int tid = threadIdx.x, wid = __builtin_amdgcn_readfirstlane(tid >> 6), lane = tid & 63, wr = wid >> 2, wc = wid & 3, fr = lane & 15, fq = lane >> 4;
    const int K = g.K, nt = K / BK;
    unsigned voffA[2], voffB[2];
#pragma unroll
    for (int i = 0; i < 2; ++i) { int R, C; stage_rc(tid * 16 + i * 8192, R, C); const int Rb = Epi::PERM ? ((R & ~31) + perm32(R & 31)) : R;
        voffA[i] = (unsigned)(R * K + C) * 2u; voffB[i] = (unsigned)(Rb * K + C) * 2u; }
    const size_t kstep = (size_t)(BK * 2);
    const size_t hstep = (size_t)HALF * K * 2;
    const size_t tstep = 2 * hstep;
    const unsigned ldsw = (unsigned)wid * 1024u;
    const int aoff = lds_byte(wr * 64 + fr, fq * 8), boff = lds_byte(wc * 32 + fr, fq * 8);
#define PG8_SA(b, h) (((b) * 2 + (h)) * HTB)
#define PG8_SB(b, h) ((4 + (b) * 2 + (h)) * HTB)
#define PG8_STAGE(bufoff, gbase, voff) do { _Pragma("unroll") for (int _i = 0; _i < 2; ++_i) \
        __builtin_amdgcn_global_load_lds((const unsigned*)((const char*)(gbase) + (voff)[_i]), (PG8_LAS unsigned*)(lds + (bufoff) + ldsw + _i * 8192), 16, 0, 0); } while (0)
#define PG8_LDA(dst, b, h) do { _Pragma("unroll") for (int m = 0; m < 4; ++m) _Pragma("unroll") for (int k = 0; k < 2; ++k) dst[m][k] = *(const PG8_LAS bf16x8*)(lds + PG8_SA(b, h) + aoff + m * 2048 + k * 1024); } while (0)
#define PG8_LDB(dst, b, h) do { _Pragma("unroll") for (int n = 0; n < 2; ++n) _Pragma("unroll") for (int k = 0; k < 2; ++k) dst[n][k] = *(const PG8_LAS bf16x8*)(lds + PG8_SB(b, h) + boff + n * 2048 + k * 1024); } while (0)
#define PG8_MMA(ai, bj, At, Bt) do { __builtin_amdgcn_s_setprio(1); _Pragma("unroll") for (int m = 0; m < 4; ++m) _Pragma("unroll") for (int n = 0; n < 2; ++n) _Pragma("unroll") for (int k = 0; k < 2; ++k) \
        acc[ai][bj][m][n] = __builtin_amdgcn_mfma_f32_16x16x32_bf16(Bt[n][k], At[m][k], acc[ai][bj][m][n], 0, 0, 0); __builtin_amdgcn_s_setprio(0); } while (0)
#define PG8_WAIT_V(n) asm volatile("s_waitcnt vmcnt(" #n ")" ::: "memory")
#define PG8_WAIT_L(n) asm volatile("s_waitcnt lgkmcnt(" #n ")" ::: "memory")
#define PG8_BAR __builtin_amdgcn_s_barrier()
#define PG8_SCHED __builtin_amdgcn_sched_barrier(0)
    Unit cur, nxt; int ui = 0;
    if (!S.next(0, cur)) return;
    f32x4 acc[2][2][4][2];
#pragma unroll
    for (int a = 0; a < 2; ++a)
#pragma unroll
        for (int b = 0; b < 2; ++b)
#pragma unroll
            for (int m = 0; m < 4; ++m)
#pragma unroll
                for (int n = 0; n < 2; ++n) acc[a][b][m][n] = (f32x4){0.f, 0.f, 0.f, 0.f};
    bf16x8 At[4][2], B0[2][2], B1[2][2];
    const char* cA = (const char*)g.A + (size_t)cur.pm * tstep; const char* cB = (const char*)g.Bt + (size_t)cur.pn * tstep;
    S.a_ready(cur);
    if constexpr (SP2) {
        PG8_STAGE(PG8_SB(0, 0), cB, voffB); PG8_STAGE(PG8_SB(0, 1), cB + hstep, voffB); PG8_STAGE(PG8_SA(0, 0), cA, voffA); PG8_STAGE(PG8_SA(0, 1), cA + hstep, voffA);
        if (wr == 1) PG8_BAR;
        PG8_WAIT_V(2); PG8_BAR;
        PG8_STAGE(PG8_SB(1, 0), cB + kstep, voffB); PG8_STAGE(PG8_SA(1, 0), cA + kstep, voffA); PG8_STAGE(PG8_SB(1, 1), cB + hstep + kstep, voffB);
        PG8_WAIT_V(6); PG8_BAR;
    } else {
        PG8_STAGE(PG8_SB(0, 0), cB, voffB); PG8_STAGE(PG8_SA(0, 0), cA, voffA); PG8_STAGE(PG8_SB(0, 1), cB + hstep, voffB); PG8_STAGE(PG8_SA(0, 1), cA + hstep, voffA);
        if (wr == 1) PG8_BAR;
        PG8_WAIT_V(4); PG8_BAR;
        PG8_STAGE(PG8_SB(1, 0), cB + kstep, voffB); PG8_STAGE(PG8_SA(1, 0), cA + kstep, voffA); PG8_STAGE(PG8_SB(1, 1), cB + hstep + kstep, voffB);
        PG8_WAIT_V(6); PG8_BAR;
    }
    for (;;) {
        const bool has_next = S.next(ui + 1, nxt);
        const char* nA = has_next ? (const char*)g.A + (size_t)nxt.pm * tstep : cA; const char* nB = has_next ? (const char*)g.Bt + (size_t)nxt.pn * tstep : cB;
        for (int t = 0; t < nt; t += 2) {
            const bool last = (t == nt - 2);
            const char* a1 = cA + (size_t)(t + 1) * kstep;
            const char* a2 = last ? nA : cA + (size_t)(t + 2) * kstep; const char* b2 = last ? nB : cB + (size_t)(t + 2) * kstep;
            const char* a3 = a2 + kstep; const char* b3 = b2 + kstep;
            if (last && has_next) S.a_ready(nxt);
            if constexpr (SP2) {
            PG8_LDB(B0, 0, 0); PG8_LDB(B1, 0, 1); PG8_SCHED; PG8_LDA(At, 0, 0); PG8_STAGE(PG8_SA(1, 1), a1 + hstep, voffA);
            PG8_WAIT_V(8); PG8_WAIT_L(0); PG8_BAR; PG8_MMA(0, 0, At, B0); PG8_MMA(0, 1, At, B1); PG8_BAR; PG8_SCHED;
            PG8_LDA(At, 0, 1); PG8_STAGE(PG8_SB(0, 0), b2, voffB); PG8_STAGE(PG8_SB(0, 1), b2 + hstep, voffB); PG8_STAGE(PG8_SA(0, 0), a2, voffA);
            PG8_WAIT_V(8); PG8_WAIT_L(0); PG8_BAR; PG8_MMA(1, 0, At, B0); PG8_MMA(1, 1, At, B1); PG8_BAR; PG8_SCHED;
            PG8_LDB(B0, 1, 0); PG8_LDB(B1, 1, 1); PG8_SCHED; PG8_LDA(At, 1, 0); PG8_STAGE(PG8_SA(0, 1), a2 + hstep, voffA);
            PG8_WAIT_V(8); PG8_WAIT_L(0); PG8_BAR; PG8_MMA(0, 0, At, B0); PG8_MMA(0, 1, At, B1); PG8_BAR; PG8_SCHED;
            PG8_LDA(At, 1, 1); PG8_STAGE(PG8_SB(1, 0), b3, voffB); PG8_STAGE(PG8_SB(1, 1), b3 + hstep, voffB); PG8_STAGE(PG8_SA(1, 0), a3, voffA);
            PG8_WAIT_V(8); PG8_WAIT_L(0); PG8_BAR; PG8_MMA(1, 0, At, B0); PG8_MMA(1, 1, At, B1); PG8_BAR; PG8_SCHED;
            } else {
            PG8_LDB(B0, 0, 0); PG8_SCHED; PG8_LDA(At, 0, 0); PG8_STAGE(PG8_SA(1, 1), a1 + hstep, voffA);
            PG8_WAIT_L(8); PG8_BAR; PG8_WAIT_L(0); PG8_MMA(0, 0, At, B0); PG8_BAR; PG8_SCHED;
            PG8_LDB(B1, 0, 1); PG8_STAGE(PG8_SB(0, 0), b2, voffB);
            PG8_BAR; PG8_WAIT_L(0); PG8_MMA(0, 1, At, B1); PG8_BAR;
            PG8_LDA(At, 0, 1); PG8_STAGE(PG8_SA(0, 0), a2, voffA);
            PG8_BAR; PG8_WAIT_L(0); PG8_MMA(1, 0, At, B0); PG8_BAR; PG8_SCHED;
            PG8_STAGE(PG8_SB(0, 1), b2 + hstep, voffB);
            PG8_WAIT_V(6); PG8_BAR; PG8_MMA(1, 1, At, B1); PG8_BAR;
            PG8_LDB(B0, 1, 0); PG8_SCHED; PG8_LDA(At, 1, 0); PG8_STAGE(PG8_SA(0, 1), a2 + hstep, voffA);
            PG8_WAIT_L(8); PG8_BAR; PG8_WAIT_L(0); PG8_MMA(0, 0, At, B0); PG8_BAR; PG8_SCHED;
            PG8_LDB(B1, 1, 1); PG8_STAGE(PG8_SB(1, 0), b3, voffB);
            PG8_BAR; PG8_WAIT_L(0); PG8_MMA(0, 1, At, B1); PG8_BAR;
            PG8_LDA(At, 1, 1); PG8_STAGE(PG8_SA(1, 0), a3, voffA);
            PG8_BAR; PG8_WAIT_L(0); PG8_MMA(1, 0, At, B0); PG8_BAR; PG8_SCHED;
            PG8_STAGE(PG8_SB(1, 1), b3 + hstep, voffB);
            PG8_WAIT_V(6); PG8_BAR; PG8_MMA(1, 1, At, B1); PG8_BAR;
            }
        }
        if constexpr (ALIGN_EPI) { if (wr == 0) PG8_BAR; }
        if constexpr (!Epi::AFTER_DRAIN) { E(acc, cur, wr, wc, fr, fq); S.done(cur); }
        if (!has_next) break;
#pragma unroll
        for (int a = 0; a < 2; ++a)
#pragma unroll
            for (int b = 0; b < 2; ++b)
#pragma unroll
                for (int m = 0; m < 4; ++m)
#pragma unroll
                    for (int n = 0; n < 2; ++n) acc[a][b][m][n] = (f32x4){0.f, 0.f, 0.f, 0.f};
        cur = nxt; cA = nA; cB = nB; ++ui;
        if constexpr (ALIGN_EPI) { if (wr == 1) PG8_BAR; }
    }
    PG8_WAIT_V(0);
    if constexpr (!ALIGN_EPI) { if (wr == 0) PG8_BAR; }
    PG8_BAR;
    if constexpr (Epi::AFTER_DRAIN) { E.fused(acc, cur, wr, wc, fr, fq, lds, wid, lane); S.done(cur); }
#undef PG8_SA
#undef PG8_SB
#undef PG8_STAGE
#undef PG8_LDA
#undef PG8_LDB
#undef PG8_MMA
#undef PG8_WAIT_V
#undef PG8_WAIT_L
#undef PG8_BAR
#undef PG8_SCHED
}
}
namespace att {
typedef unsigned short bf16_t;
typedef short bf16x8 __attribute__((ext_vector_type(8)));
typedef short s16x4 __attribute__((ext_vector_type(4)));
typedef short v4i16_t __attribute__((ext_vector_type(4)));
typedef float f32x16 __attribute__((ext_vector_type(16)));
typedef unsigned u32x4 __attribute__((ext_vector_type(4)));
typedef unsigned u32x2 __attribute__((ext_vector_type(2)));
#define ATT_LAS __attribute__((address_space(3)))
#define DI __device__ __forceinline__
constexpr int SEQ = 8192, LDQ = 3840;
constexpr int QA = 0, KA = 768, VA = 1536, QB = 2304, KB = 2816, VB = 3328;
constexpr int VROW = 192;
constexpr int VL_BYTES = 32 * VROW;
constexpr float LOG2E = 1.4426950408889634f;
#define MFMA32(a, b, c) __builtin_amdgcn_mfma_f32_32x32x16_bf16((a), (b), (c), 0, 0, 0)
DI int crow(int i, int h) { return (i & 3) + 8 * (i >> 2) + 4 * h; }
DI unsigned cvtpk(float lo, float hi) { typedef float f2_t __attribute__((ext_vector_type(2))); typedef __bf16 b2_t __attribute__((ext_vector_type(2))); f2_t v = {lo, hi}; b2_t b = __builtin_convertvector(v, b2_t); return __builtin_bit_cast(unsigned, b); }
DI s16x4 vtr(ATT_LAS const char* p) { return __builtin_bit_cast(s16x4, __builtin_amdgcn_ds_read_tr16_b64_v4i16((ATT_LAS v4i16_t*)p)); }
DI void swap32(float v, float& x0, float& x1) { float a = v, b = v; asm volatile("s_nop 1\n\tv_permlane32_swap_b32_e32 %0, %1\n\ts_nop 1" : "+v"(a), "+v"(b)); x0 = a; x1 = b; }
DI float swap_max(float v) { float x0, x1; swap32(v, x0, x1); return __builtin_fmaxf(x0, x1); }
DI float swap_sum(float v) { float x0, x1; swap32(v, x0, x1); return x0 + x1; }
DI void stage_v(ATT_LAS char* vl, int lane, const u32x4 (&vr)[4]) {
#pragma unroll
    for (int i = 0; i < 4; ++i) *(ATT_LAS u32x4*)(vl + ((lane >> 3) + 8 * i) * VROW + (lane & 7) * 16) = vr[i];
}
DI void pv_step(f32x16& o0, f32x16& o1, ATT_LAS const char* vl, int lane, const float (&a)[16]) {
    const int hi = lane >> 5, q = (lane & 15) >> 2, p = lane & 3, blk = (lane >> 4) & 1;
    ATT_LAS const char* base = vl + (4 * hi + q) * VROW + blk * 32 + p * 8;
#pragma unroll
    for (int s = 0; s < 2; ++s) {
        u32x4 pw; pw.x = cvtpk(a[8 * s + 0], a[8 * s + 1]); pw.y = cvtpk(a[8 * s + 2], a[8 * s + 3]); pw.z = cvtpk(a[8 * s + 4], a[8 * s + 5]); pw.w = cvtpk(a[8 * s + 6], a[8 * s + 7]);
        const bf16x8 pf = __builtin_bit_cast(bf16x8, pw);
        { const s16x4 lo = vtr(base + (16 * s) * VROW), hh = vtr(base + (16 * s + 8) * VROW);
          const bf16x8 vt = __builtin_shufflevector(lo, hh, 0, 1, 2, 3, 4, 5, 6, 7); o0 = MFMA32(vt, pf, o0); }
        { const s16x4 lo = vtr(base + (16 * s) * VROW + 64), hh = vtr(base + (16 * s + 8) * VROW + 64);
          const bf16x8 vt = __builtin_shufflevector(lo, hh, 0, 1, 2, 3, 4, 5, 6, 7); o1 = MFMA32(vt, pf, o1); }
    }
}
DI void store_o(bf16_t* orow, const f32x16& o0, const f32x16& o1, int hi, float sc) {
#pragma unroll
    for (int g = 0; g < 4; ++g) {
        u32x2 w0, w1; w0.x = cvtpk(o0[4 * g] * sc, o0[4 * g + 1] * sc); w0.y = cvtpk(o0[4 * g + 2] * sc, o0[4 * g + 3] * sc);
        w1.x = cvtpk(o1[4 * g] * sc, o1[4 * g + 1] * sc); w1.y = cvtpk(o1[4 * g + 2] * sc, o1[4 * g + 3] * sc);
        *(u32x2*)(orow + 8 * g + 4 * hi) = w0; *(u32x2*)(orow + 32 + 8 * g + 4 * hi) = w1;
    }
}

template <bool EARLY_EXIT>
DI void sb_unit(const bf16_t* __restrict__ qkv, bf16_t* __restrict__ ob, int b, int h, int qblk, ATT_LAS char* vl, int lane) {
    const int r32 = lane & 31, hi = lane >> 5;
    const size_t rowb = (size_t)b * SEQ; const int q0 = qblk * 32;
    const bf16_t* Qp = qkv + (rowb + q0 + r32) * LDQ + QB + h * 64 + 8 * hi;
    bf16x8 qf[4];
#pragma unroll
    for (int d0 = 0; d0 < 4; ++d0) qf[d0] = *(const bf16x8*)(Qp + 16 * d0);
    const bf16_t* Kp = qkv + (rowb + r32) * LDQ + KB + h * 64 + 8 * hi;
    const bf16_t* Vp = qkv + (rowb + (lane >> 3)) * LDQ + VB + h * 64 + (lane & 7) * 8;
    f32x16 o0, o1;
#pragma unroll
    for (int i = 0; i < 16; ++i) { o0[i] = 0.f; o1[i] = 0.f; }
    float carry = 1.f;
    bf16x8 kf[4]; u32x4 vr[4];
    { const size_t ko = (size_t)q0 * LDQ;
#pragma unroll
      for (int d0 = 0; d0 < 4; ++d0) kf[d0] = *(const bf16x8*)(Kp + ko + 16 * d0);
#pragma unroll
      for (int i = 0; i < 4; ++i) vr[i] = *(const u32x4*)(Vp + ko + (size_t)(8 * i) * LDQ); }
#pragma unroll 1
    for (int kt = qblk; kt >= 0; --kt) {
        bf16x8 kn[4]; u32x4 vn[4];
        { const int ktn = kt > 0 ? kt - 1 : 0; const size_t ko = (size_t)(ktn * 32) * LDQ;
#pragma unroll
          for (int d0 = 0; d0 < 4; ++d0) kn[d0] = *(const bf16x8*)(Kp + ko + 16 * d0);
#pragma unroll
          for (int i = 0; i < 4; ++i) vn[i] = *(const u32x4*)(Vp + ko + (size_t)(8 * i) * LDQ); }
        stage_v(vl, lane, vr);
        f32x16 s;
#pragma unroll
        for (int i = 0; i < 16; ++i) s[i] = 0.f;
#pragma unroll
        for (int d0 = 0; d0 < 4; ++d0) s = MFMA32(kf[d0], qf[d0], s);
        if (kt == qblk) {
#pragma unroll
            for (int i = 0; i < 16; ++i) if (crow(i, hi) >= r32) s[i] = -__builtin_inff();
        }
        float r[16], a[16], T[4], To[4], PT[4];
#pragma unroll
        for (int i = 0; i < 16; ++i) r[i] = __builtin_amdgcn_rcpf(1.f + __builtin_amdgcn_exp2f(s[i]));
#pragma unroll
        for (int g = 0; g < 4; ++g) {
            const float c2 = r[4 * g + 3], c1 = r[4 * g + 2] * c2, c0 = r[4 * g + 1] * c1;
            T[g] = r[4 * g] * c0;
            a[4 * g + 3] = (1.f - r[4 * g + 3]);
            a[4 * g + 2] = (1.f - r[4 * g + 2]) * c2;
            a[4 * g + 1] = (1.f - r[4 * g + 1]) * c1;
            a[4 * g + 0] = (1.f - r[4 * g + 0]) * c0;
            float x0, x1; swap32(T[g], x0, x1);
            const float oth = (__builtin_bit_cast(unsigned, x0) == __builtin_bit_cast(unsigned, T[g])) ? x1 : x0;
            To[g] = hi ? 1.f : oth;
            PT[g] = x0 * x1;
        }
        const float S3 = carry, S2 = S3 * PT[3], S1 = S2 * PT[2], S0 = S1 * PT[1];
        const float off3 = S3 * To[3], off2 = S2 * To[2], off1 = S1 * To[1], off0 = S0 * To[0];
        carry = S0 * PT[0];
#pragma unroll
        for (int j = 0; j < 4; ++j) { a[j] *= off0; a[4 + j] *= off1; a[8 + j] *= off2; a[12 + j] *= off3; }
        pv_step(o0, o1, vl, lane, a);
        if (EARLY_EXIT) { if (__builtin_amdgcn_ballot_w64(carry != 0.f) == 0ull) break; }
#pragma unroll
        for (int d0 = 0; d0 < 4; ++d0) kf[d0] = kn[d0];
#pragma unroll
        for (int i = 0; i < 4; ++i) vr[i] = vn[i];
    }
    store_o(ob + (rowb + q0 + r32) * 512 + h * 64, o0, o1, hi, 1.f);
}

DI void dil_unit(const bf16_t* __restrict__ qkv, bf16_t* __restrict__ oa, int b, int j, int t0, ATT_LAS char* vl, int lane) {
    const int r32 = lane & 31, hi = lane >> 5;
    const size_t rowb = (size_t)b * SEQ;
    f32x16 o0, o1;
#pragma unroll
    for (int i = 0; i < 16; ++i) { o0[i] = 0.f; o1[i] = 0.f; }
    float m = -1e30f, l = 0.f;
#pragma unroll 1
    for (int g = 0; g < 3; ++g) {
        const int sh = 2 * g, d = 1 << sh, hg = 4 * g + j, NT = (g == 0) ? 20 : (g == 1 ? 8 : 5);
        const float slope2 = exp2f(-8.f * (float)(hg + 1) / 12.f) * (float)d * LOG2E;
        const int c = ((16 * r32) >> sh) + 128;
        const int nmin = 128 - (t0 >> sh);
        const int ubase = t0 - 128 * d;
        const bf16_t* Qp = qkv + (rowb + t0 + 16 * r32) * LDQ + QA + hg * 64 + 8 * hi;
        bf16x8 qf[4];
#pragma unroll
        for (int d0 = 0; d0 < 4; ++d0) qf[d0] = *(const bf16x8*)(Qp + 16 * d0);
        const bf16_t* Kh = qkv + rowb * LDQ + KA + hg * 64 + 8 * hi;
        const bf16_t* Vh = qkv + rowb * LDQ + VA + hg * 64 + (lane & 7) * 8;
        int tile = 0;
        while ((tile + 1) * 32 <= nmin) ++tile;
        bf16x8 kf[4]; u32x4 vr[4];
#define DIL_LOAD(KF, VR, TL) do { const int n0_ = 32 * (TL); int uk = ubase + d * (n0_ + r32); uk = uk < 0 ? 0 : (uk > SEQ - 1 ? SEQ - 1 : uk); \
            _Pragma("unroll") for (int d0 = 0; d0 < 4; ++d0) KF[d0] = *(const bf16x8*)(Kh + (size_t)uk * LDQ + 16 * d0); \
            _Pragma("unroll") for (int i = 0; i < 4; ++i) { int uv = ubase + d * (n0_ + (lane >> 3) + 8 * i); uv = uv < 0 ? 0 : (uv > SEQ - 1 ? SEQ - 1 : uv); VR[i] = *(const u32x4*)(Vh + (size_t)uv * LDQ); } } while (0)
        DIL_LOAD(kf, vr, tile);
#pragma unroll 1
        for (; tile < NT; ++tile) {
            bf16x8 kn[4]; u32x4 vn[4];
            { const int tn = tile + 1 < NT ? tile + 1 : tile; DIL_LOAD(kn, vn, tn); }
            stage_v(vl, lane, vr);
            f32x16 s;
#pragma unroll
            for (int i = 0; i < 16; ++i) s[i] = 0.f;
#pragma unroll
            for (int d0 = 0; d0 < 4; ++d0) s = MFMA32(kf[d0], qf[d0], s);
            const int n0 = 32 * tile;
            float lg[16]; float mx = -1e30f;
#pragma unroll
            for (int i = 0; i < 16; ++i) { const int n = n0 + crow(i, hi), step = c - n; const bool valid = ((unsigned)step <= 128u) && (n >= nmin);
                lg[i] = valid ? (s[i] - slope2 * (float)step) : -1e30f; mx = __builtin_fmaxf(mx, lg[i]); }
            mx = swap_max(mx);
            const float mn = __builtin_fmaxf(m, mx), alpha = __builtin_amdgcn_exp2f(m - mn);
            m = mn;
            float ps = 0.f;
#pragma unroll
            for (int i = 0; i < 16; ++i) { lg[i] = __builtin_amdgcn_exp2f(lg[i] - mn); ps += lg[i]; }
            l = l * alpha + ps;
#pragma unroll
            for (int i = 0; i < 16; ++i) { o0[i] *= alpha; o1[i] *= alpha; }
            pv_step(o0, o1, vl, lane, lg);
#pragma unroll
            for (int d0 = 0; d0 < 4; ++d0) kf[d0] = kn[d0];
#pragma unroll
            for (int i = 0; i < 4; ++i) vr[i] = vn[i];
        }
#undef DIL_LOAD
    }
    l = swap_sum(l);
    store_o(oa + (rowb + t0 + 16 * r32) * 256 + j * 64, o0, o1, hi, 1.f / l);
}
#undef DI
}
namespace cg = cooperative_groups;
#define LAS __attribute__((address_space(3)))
typedef unsigned short bf16;
typedef unsigned v4u __attribute__((ext_vector_type(4)));
typedef float f32x4 __attribute__((ext_vector_type(4)));
constexpr int NWAVES = 8;
constexpr int M = 16384, D = 1024, FF = 4096, NPROJ = 5888;
constexpr float RMS_EPS = 1e-6f;
#ifndef SB_EARLY_EXIT
#define SB_EARLY_EXIT true
#endif
constexpr size_t MiB = 1u << 20;
constexpr size_t WS_WIN = 1 * MiB, WS_WUD = 13 * MiB, WS_WUS = 14 * MiB, WS_WO = 15 * MiB, WS_W1 = 17 * MiB, WS_W2 = 25 * MiB;
constexpr size_t WS_R1 = 33 * MiB;
constexpr size_t WS_OA = WS_R1, WS_OB = WS_R1 + 8 * MiB;
constexpr size_t WS_QKV = 65 * MiB;
constexpr size_t WS_G = 185 * MiB;
constexpr size_t WS_END = 249 * MiB;
constexpr int LDS_BYTES = 147456;
static_assert(NWAVES * att::VL_BYTES <= pg8::STAGE_BYTES && pg8::STAGE_BYTES <= LDS_BYTES, "LDS map");

__device__ __forceinline__ float wave_sum(float v) {
#pragma unroll
    for (int o = 1; o < 64; o <<= 1) v += __shfl_xor(v, o);
    return v;
}
__device__ __forceinline__ unsigned f2bf(float f) { unsigned u = __builtin_bit_cast(unsigned, f); return (u + 0x7fffu + ((u >> 16) & 1u)) >> 16; }
__device__ __forceinline__ unsigned pk2(float lo, float hi) { return f2bf(lo) | (f2bf(hi) << 16); }
__device__ __forceinline__ void p0_transpose_item(const float* W, int K, int N, bf16* WT, LAS float* scr, int item, int lane) {
    const int nblk = N / 32, kb = item / nblk, nb = item % nblk, k0 = 64 * kb, n0 = 32 * nb;
#pragma unroll 8
    for (int i = 0; i < 32; ++i) { const int kk = 2 * i + (lane >> 5); scr[kk * 33 + (lane & 31)] = W[(size_t)(k0 + kk) * N + n0 + (lane & 31)]; }
    asm volatile("s_waitcnt lgkmcnt(0)" ::: "memory");
    const int c = lane & 7;
#pragma unroll
    for (int j = 0; j < 4; ++j) { const int n = (lane >> 3) + 8 * j; const LAS float* s = scr + (8 * c) * 33 + n;
        v4u o; o.x = pk2(s[0 * 33], s[1 * 33]); o.y = pk2(s[2 * 33], s[3 * 33]); o.z = pk2(s[4 * 33], s[5 * 33]); o.w = pk2(s[6 * 33], s[7 * 33]);
        *(v4u*)(WT + (size_t)(n0 + n) * K + k0 + 8 * c) = o; }
    asm volatile("s_waitcnt lgkmcnt(0)" ::: "memory");
}
__device__ __forceinline__ void rms_row_to_bf16(const float* xrow, const float* g, bf16* orow, int lane) {
    const f32x4* xr = (const f32x4*)xrow + lane; const f32x4* gr = (const f32x4*)g + lane;
    f32x4 v[4]; float s = 0.f;
#pragma unroll
    for (int j = 0; j < 4; ++j) { v[j] = xr[64 * j]; s += (v[j].x * v[j].x + v[j].y * v[j].y) + (v[j].z * v[j].z + v[j].w * v[j].w); }
    const float rstd = 1.f / sqrtf(wave_sum(s) * (1.f / D) + RMS_EPS);
    unsigned long long* o8 = (unsigned long long*)orow + lane;
#pragma unroll
    for (int j = 0; j < 4; ++j) { const f32x4 gv = gr[64 * j]; o8[64 * j] = (unsigned long long)pk2(v[j].x * rstd * gv.x, v[j].y * rstd * gv.y) | ((unsigned long long)pk2(v[j].z * rstd * gv.z, v[j].w * rstd * gv.w) << 32); }
}
__device__ __forceinline__ void rms_row_inplace(float* xrow, const float* g, int lane) {
    f32x4* xr = (f32x4*)xrow + lane; const f32x4* gr = (const f32x4*)g + lane;
    f32x4 v[4]; float s = 0.f;
#pragma unroll
    for (int j = 0; j < 4; ++j) { v[j] = xr[64 * j]; s += (v[j].x * v[j].x + v[j].y * v[j].y) + (v[j].z * v[j].z + v[j].w * v[j].w); }
    const float rstd = 1.f / sqrtf(wave_sum(s) * (1.f / D) + RMS_EPS);
#pragma unroll
    for (int j = 0; j < 4; ++j) { const f32x4 gv = gr[64 * j]; xr[64 * j] = v[j] * rstd * gv; }
}

#define XB_TMO      128
#define XB_XCNT(j)  (256  + 64 * (j))
#define XB_XSUB(j)  (1280 + 64 * (j))
#define XB_XGEN(j)  (2304 + 64 * (j))
#define XB_TOP      3328
#define XB_TOPGEN   3392
#define XCD_BAR_WORDS 3456
#define XB_SPIN_CAP (1u << 18)

__device__ __forceinline__ unsigned xb_ld(unsigned* p)              { return __hip_atomic_load(p, __ATOMIC_RELAXED, __HIP_MEMORY_SCOPE_AGENT); }
__device__ __forceinline__ unsigned xb_add(unsigned* p, unsigned v) { return __hip_atomic_fetch_add(p, v, __ATOMIC_RELAXED, __HIP_MEMORY_SCOPE_AGENT); }
__device__ __forceinline__ unsigned xb_xcc_id() { return (unsigned)__builtin_amdgcn_s_getreg((3 << 11) | 20) & 0xFu; }
#define XB_SPIN(cond, bar) do { unsigned _sp = 0; while (cond) { __builtin_amdgcn_s_sleep(1); \
    if ((++_sp & 255u) == 0u) { if (xb_ld(&(bar)[XB_TMO])) break; if (_sp > XB_SPIN_CAP) { atomicAdd(&(bar)[XB_TMO], 1u); break; } } } } while (0)

struct XcdBarrier {
    unsigned* bar; unsigned x;
    volatile LAS unsigned* st;
};

__device__ __forceinline__ XcdBarrier xcd_barrier_post(unsigned* bar, volatile LAS unsigned* st) {
    XcdBarrier b; b.bar = bar; b.x = xb_xcc_id(); b.st = st;
    if (threadIdx.x == 0) (void)xb_add(&bar[XB_XCNT(b.x)], 1u);
    return b;
}
__device__ __forceinline__ void xcd_barrier_complete(unsigned* bar, unsigned x, unsigned& nloc, unsigned& nx) {
    const unsigned G = gridDim.x * gridDim.y * gridDim.z;
    unsigned sum, cnt, mine, sp = 0u;
    for (;;) {
        sum = 0u; cnt = 0u; mine = 0u;
#pragma unroll
        for (unsigned j = 0; j < 16; ++j) { const unsigned c = xb_ld(&bar[XB_XCNT(j)]); sum += c; cnt += (c > 0u) ? 1u : 0u; mine = (j == x) ? c : mine; }
        if (sum == G) break;
        __builtin_amdgcn_s_sleep(1);
        if ((++sp & 255u) == 0u) { if (xb_ld(&bar[XB_TMO])) break; if (sp > XB_SPIN_CAP) { atomicAdd(&bar[XB_TMO], 1u); break; } }
    }
    nloc = mine > 0u ? mine : 1u; nx = cnt > 0u ? cnt : 1u;
}

__device__ __forceinline__ void xcd_barrier(const XcdBarrier& b) {
    asm volatile("s_waitcnt vmcnt(0)" ::: "memory");
    __syncthreads();
    if (threadIdx.x == 0) {
        unsigned* bar = b.bar;
        __builtin_amdgcn_s_waitcnt(0);
        unsigned nloc = b.st[0], nx = b.st[1];
        if (nloc == 0u) { xcd_barrier_complete(bar, b.x, nloc, nx); b.st[0] = nloc; b.st[1] = nx; }
        const unsigned old = xb_add(&bar[XB_XSUB(b.x)], 1u);
        const unsigned gen = old / nloc;
        if (old + 1u == (gen + 1u) * nloc) {
            __builtin_amdgcn_fence(__ATOMIC_RELEASE, "agent");
            asm volatile("s_waitcnt vmcnt(0)" ::: "memory");
            const unsigned og = xb_add(&bar[XB_TOP], 1u);
            const unsigned tg = og / nx;
            if (og + 1u == (tg + 1u) * nx) xb_add(&bar[XB_TOPGEN], 1u);
            else XB_SPIN(xb_ld(&bar[XB_TOPGEN]) == tg, bar);
            __builtin_amdgcn_fence(__ATOMIC_ACQUIRE, "agent");
            xb_add(&bar[XB_XGEN(b.x)], 1u);
            asm volatile("s_waitcnt vmcnt(0)" ::: "memory");
        } else {
            XB_SPIN(xb_ld(&bar[XB_XGEN(b.x)]) == gen, bar);
            __builtin_amdgcn_fence(__ATOMIC_ACQUIRE, "agent");
            asm volatile("s_waitcnt vmcnt(0)" ::: "memory");
        }
    }
    __syncthreads();
}

struct Args { const float* x; const float* g_mix; const float* w_in; const float* b_gate; const float* w_up_dil; const float* w_up_sb; const float* w_out;
              const float* g_mlp; const float* w_mlp_in; const float* w_mlp_out; const float* g_final; float* out; unsigned char* ws; int ph_lo, ph_hi; };
constexpr int N_PHASES = 9;

__global__ void __launch_bounds__(NWAVES * 64, 2) fwd_megakernel(Args a) {
    extern __shared__ __attribute__((aligned(16))) unsigned char lds_raw[];
    LAS unsigned char* lds = (LAS unsigned char*)lds_raw;
    const int tid = threadIdx.x, lane = tid & 63, wave = __builtin_amdgcn_readfirstlane(tid >> 6);
    const int G = gridDim.x, gw = blockIdx.x * NWAVES + wave, NGW = G * NWAVES;
    unsigned char* ws = a.ws;
    bf16* Win_t = (bf16*)(ws + WS_WIN); bf16* Wud_t = (bf16*)(ws + WS_WUD); bf16* Wus_t = (bf16*)(ws + WS_WUS); bf16* Wo_t = (bf16*)(ws + WS_WO);
    bf16* W1_t = (bf16*)(ws + WS_W1); bf16* W2_t = (bf16*)(ws + WS_W2);
    bf16* R1 = (bf16*)(ws + WS_R1); bf16* OA = (bf16*)(ws + WS_OA); bf16* OB = (bf16*)(ws + WS_OB);
    bf16* QKV = (bf16*)(ws + WS_QKV); bf16* GATES = (bf16*)(ws + WS_G);
    bf16* MERGED = QKV; bf16* UB = QKV;
    const int lo = a.ph_lo, hi = a.ph_hi;
#ifndef DBG_STOP
#define DBG_STOP 99
#endif
#define IN(k) (lo <= (k) && (k) < hi && (k) <= DBG_STOP)
#define SEAM(k) do { if (IN(k) && IN((k) + 1)) xcd_barrier(bar); } while (0)
    for (int u = tid; u < (LDS_BYTES - pg8::STAGE_BYTES) / 4; u += NWAVES * 64) ((LAS unsigned*)(lds + pg8::STAGE_BYTES))[u] = 0u;
    __syncthreads();
    XcdBarrier bar = xcd_barrier_post((unsigned*)ws, (volatile LAS unsigned*)(lds + pg8::STAGE_BYTES + 320) + 8);
    if (lo < 0) cg::this_grid().sync();

    if (IN(0)) {
        LAS float* scr = (LAS float*)(lds + wave * 16384);
        constexpr int I_IN = (D / 64) * (NPROJ / 32), I_UD = (256 / 64) * (D / 32), I_US = (512 / 64) * (D / 32), I_O = (D / 64) * (D / 32), I_1 = (D / 64) * (FF / 32), I_2 = (FF / 64) * (D / 32);
        constexpr int NITEMS = I_IN + I_UD + I_US + I_O + I_1 + I_2;
        for (int it = gw; it < NITEMS; it += NGW) {
            int r = it;
            if (r < I_IN) { p0_transpose_item(a.w_in, D, NPROJ, Win_t, scr, r, lane); continue; } r -= I_IN;
            if (r < I_UD) { p0_transpose_item(a.w_up_dil, 256, D, Wud_t, scr, r, lane); continue; } r -= I_UD;
            if (r < I_US) { p0_transpose_item(a.w_up_sb, 512, D, Wus_t, scr, r, lane); continue; } r -= I_US;
            if (r < I_O) { p0_transpose_item(a.w_out, D, D, Wo_t, scr, r, lane); continue; } r -= I_O;
            if (r < I_1) { p0_transpose_item(a.w_mlp_in, D, FF, W1_t, scr, r, lane); continue; } r -= I_1;
            p0_transpose_item(a.w_mlp_out, FF, D, W2_t, scr, r, lane);
        }
        for (int m = gw; m < M; m += NGW) rms_row_to_bf16(a.x + (size_t)m * D, a.g_mix, R1 + (size_t)m * D, lane);
        asm volatile("s_waitcnt vmcnt(0) lgkmcnt(0)" ::: "memory"); __syncthreads();
    }
    SEAM(0);
    if (IN(1)) {
        pg8::Gemm g{R1, Win_t, M, NPROJ, D}; pg8::StaticOrder S; S.init(M, NPROJ, G, (int)blockIdx.x);
        pg8::EpiProj E{QKV, GATES, a.b_gate};
        pg8::gemm_phase<pg8::EpiProj, pg8::StaticOrder, true, true>(lds, g, S, E);
    }
    SEAM(1);
    if (IN(2)) {
        ATT_LAS char* vl = (ATT_LAS char*)(lds + wave * att::VL_BYTES);
        for (int id = gw; id < 2048; id += NGW) att::dil_unit(QKV, OA, id >> 10, (id >> 4) & 3, 512 * ((id >> 6) & 15) + (id & 15), vl, lane);
        for (int id = gw; id < 4096; id += NGW) att::sb_unit<SB_EARLY_EXIT>(QKV, OB, id >> 11, (id >> 8) & 7, id & 255, vl, lane);
        asm volatile("s_waitcnt vmcnt(0) lgkmcnt(0)" ::: "memory"); __syncthreads();
    }
    SEAM(2);
    if (IN(3)) {
        pg8::StaticOrder S; S.init(M, D, G, (int)blockIdx.x);
        { pg8::Gemm g{OB, Wus_t, M, D, 512}; pg8::EpiUp<true> E{MERGED, GATES, 1024};
          pg8::gemm_phase<pg8::EpiUp<true>, pg8::StaticOrder, true, true>(lds, g, S, E); }
        { pg8::Gemm g{OA, Wud_t, M, D, 256}; pg8::EpiUp<false> E{MERGED, GATES, 0};
          pg8::gemm_phase<pg8::EpiUp<false>, pg8::StaticOrder, true, true>(lds, g, S, E); }
    }
    SEAM(3);
    if (IN(4)) {
        pg8::Gemm g{MERGED, Wo_t, M, D, D}; pg8::StaticOrder S; S.init(M, D, G, (int)blockIdx.x);
        pg8::EpiRes E{a.x, a.out};
        pg8::gemm_phase<pg8::EpiRes, pg8::StaticOrder, true, true>(lds, g, S, E);
    }
    SEAM(4);
    if (IN(5)) {
        for (int m = gw; m < M; m += NGW) rms_row_to_bf16(a.out + (size_t)m * D, a.g_mlp, R1 + (size_t)m * D, lane);
    }
    SEAM(5);
    if (IN(6)) {
        pg8::Gemm g{R1, W1_t, M, FF, D}; pg8::StaticOrder S; S.init(M, FF, G, (int)blockIdx.x);
        pg8::EpiRelu2 E{UB};
        pg8::gemm_phase<pg8::EpiRelu2, pg8::StaticOrder, true, true>(lds, g, S, E);
    }
    SEAM(6);
    if (IN(7)) {
        pg8::Gemm g{UB, W2_t, M, D, FF}; pg8::StaticOrder S; S.init(M, D, G, (int)blockIdx.x);
        pg8::EpiRes E{a.out, a.out};
        pg8::gemm_phase<pg8::EpiRes, pg8::StaticOrder, true, true>(lds, g, S, E);
    }
    SEAM(7);
    if (IN(8)) {
        for (int m = gw; m < M; m += NGW) rms_row_inplace(a.out + (size_t)m * D, a.g_final, lane);
    }
#if DBG_STOP < 99
    if (lo <= 8 && 8 < hi) {
        const bf16* src = (const bf16*)(ws + DBG_OFF); const size_t n = (size_t)DBG_N;
        for (size_t i = (size_t)blockIdx.x * 512 + tid; i < (size_t)M * D; i += (size_t)G * 512) { float acc = 0.f; for (size_t j = i; j < n; j += (size_t)M * D) acc += __builtin_bit_cast(float, (unsigned)src[j] << 16); a.out[i] = acc; }
    }
#endif
#undef IN
#undef SEAM
}

#ifndef MK_N_LAUNCHES
#define MK_N_LAUNCHES 1
#endif
extern "C" void kernel_launch(void* const* d_in, const int* in_sizes, int n_in, void* d_out, int out_size, void* d_ws, size_t ws_size, hipStream_t stream) {
    static int grid = 0;
    if (grid == 0) {
        if (n_in != 11 || in_sizes[0] != M * D || out_size != M * D || ws_size < WS_END) { fprintf(stderr, "kernel_launch: unexpected shapes (n_in %d, in0 %d, out %d, ws %zu); nothing launched\n", n_in, n_in > 0 ? in_sizes[0] : -1, out_size, ws_size); grid = -1; return; }
        int dev = 0, cus = 0, per_cu = 0;
        if (hipGetDevice(&dev) != hipSuccess || hipDeviceGetAttribute(&cus, hipDeviceAttributeMultiprocessorCount, dev) != hipSuccess) { grid = -1; return; }
        if (hipFuncSetAttribute((const void*)fwd_megakernel, hipFuncAttributeMaxDynamicSharedMemorySize, LDS_BYTES) != hipSuccess) { fprintf(stderr, "kernel_launch: hipFuncSetAttribute failed\n"); grid = -1; return; }
        if (hipOccupancyMaxActiveBlocksPerMultiprocessor(&per_cu, (const void*)fwd_megakernel, NWAVES * 64, LDS_BYTES) != hipSuccess || per_cu < 1) { fprintf(stderr, "kernel_launch: occupancy query says %d blocks per CU\n", per_cu); per_cu = 1; }
        (void)hipGetLastError();
        grid = cus * per_cu;
    }
    if (grid < 0) return;
    if (hipMemsetAsync(d_ws, 0, 16384, stream) != hipSuccess) { fprintf(stderr, "kernel_launch: memset of the barrier words failed\n"); return; }
    Args a{};
    a.x = (const float*)d_in[0]; a.g_mix = (const float*)d_in[1]; a.w_in = (const float*)d_in[2]; a.b_gate = (const float*)d_in[3];
    a.w_up_dil = (const float*)d_in[4]; a.w_up_sb = (const float*)d_in[5]; a.w_out = (const float*)d_in[6]; a.g_mlp = (const float*)d_in[7];
    a.w_mlp_in = (const float*)d_in[8]; a.w_mlp_out = (const float*)d_in[9]; a.g_final = (const float*)d_in[10];
    a.out = (float*)d_out; a.ws = (unsigned char*)d_ws;
#if MK_N_LAUNCHES == 1
    a.ph_lo = 0; a.ph_hi = N_PHASES;
    void* args[] = {&a};
    hipError_t e = hipLaunchCooperativeKernel((const void*)fwd_megakernel, dim3(grid), dim3(NWAVES * 64), args, LDS_BYTES, stream);
    if (e != hipSuccess) fprintf(stderr, "kernel_launch: cooperative launch failed: %s (grid %d)\n", hipGetErrorString(e), grid);
#else
    for (int p = 0; p < N_PHASES; ++p) { a.ph_lo = p; a.ph_hi = p + 1; hipLaunchKernelGGL(fwd_megakernel, dim3(grid), dim3(NWAVES * 64), LDS_BYTES, stream, a); }
#endif
}
```
